# Optimizing an MI355X kernel written in HIP

```python
import math
import jax, jax.numpy as jnp
from jax import lax
import numpy as np

D_MODEL = 1024
BATCH = 8
SEQ = 2048
DEPTH = 1

RET_HEADS = 4
RET_QK_DIM = D_MODEL // RET_HEADS
RET_V_DIM = 2 * RET_QK_DIM
RET_CHUNK = 128
DIFF_HEAD_DIM = 64
DIFF_HEADS = D_MODEL // (2 * DIFF_HEAD_DIM)
DIFF_V_DIM = 2 * DIFF_HEAD_DIM
Q_BLOCK = 128
D_FF = 2816
N_BRANCH = 2
N_SUB = 3
N_MOD = 3
EPS = 1e-6

RET_QK_W = RET_HEADS * RET_QK_DIM
RET_V_W = RET_HEADS * RET_V_DIM
DIFF_QK_W = DIFF_HEADS * 2 * DIFF_HEAD_DIM
DIFF_V_W = DIFF_HEADS * DIFF_V_DIM
GATE_W = N_BRANCH * D_MODEL
IN_W = 2 * RET_QK_W + 2 * RET_V_W + 2 * DIFF_QK_W + DIFF_V_W + GATE_W
SPLIT_POINTS = (
    RET_QK_W,
    2 * RET_QK_W,
    2 * RET_QK_W + RET_V_W,
    2 * RET_QK_W + 2 * RET_V_W,
    2 * RET_QK_W + 2 * RET_V_W + DIFF_QK_W,
    2 * RET_QK_W + 2 * RET_V_W + 2 * DIFF_QK_W,
    2 * RET_QK_W + 2 * RET_V_W + 2 * DIFF_QK_W + DIFF_V_W,
)

kernel_name = "hybrid_retention_diffattn_macaron_adaln"


def lambda_init(layer_idx):
    return 0.8 - 0.6 * math.exp(-0.3 * layer_idx)


def rmsnorm(x, g):
    xf = x.astype(jnp.float32)
    y = xf * lax.rsqrt(jnp.mean(xf * xf, axis=-1, keepdims=True) + EPS)
    return (y * g.astype(jnp.float32)).astype(x.dtype)


def modulate(x, g, shift, scale):
    return rmsnorm(x, g) * (1 + scale[:, None, :]) + shift[:, None, :]


def swiglu(h, w_in, w_out):
    a, b = jnp.split(h @ w_in, 2, axis=-1)
    return (jax.nn.silu(a) * b) @ w_out


def retention_chunkwise(q, k, v):
    B, S, H, dk = q.shape
    dv = v.shape[-1]
    C = RET_CHUNK
    N = S // C
    log_g = jnp.log1p(-jnp.exp2(-5.0 - jnp.arange(H, dtype=jnp.float32)))
    pos = jnp.arange(C, dtype=jnp.float32)
    rel = pos[:, None] - pos[None, :]
    decay_intra = jnp.where(rel[None] >= 0,
                            jnp.exp(jnp.maximum(rel, 0.0)[None] * log_g[:, None, None]),
                            0.0)
    xi = jnp.exp((pos + 1.0)[None, :] * log_g[:, None])[..., None]
    zeta = jnp.exp((C - 1.0 - pos)[None, :] * log_g[:, None])[..., None]
    g_chunk = jnp.exp(C * log_g)[:, None, None]

    def to_chunks(t):
        return t.reshape(B, N, C, H, t.shape[-1]).transpose(1, 0, 3, 2, 4)

    def step(R, inp):
        qc, kc, vc = inp
        intra = jnp.einsum('bhcd,bhsd->bhcs', qc, kc) * decay_intra
        o = (jnp.einsum('bhcs,bhse->bhce', intra, vc)
             + jnp.einsum('bhcd,bhde->bhce', qc, R) * xi)
        R = R * g_chunk + jnp.einsum('bhsd,bhse->bhde', kc * zeta, vc)
        return R, o

    R0 = jnp.zeros((B, H, dk, dv), jnp.float32)
    _, o = lax.scan(step, R0, (to_chunks(q), to_chunks(k), to_chunks(v)))
    return o.transpose(1, 0, 3, 2, 4).reshape(B, S, H, dv)


def diff_attention(q, k, v, lam):
    B, H, _, S, dh = q.shape
    dv = v.shape[-1]
    nb = S // Q_BLOCK
    scale = dh ** -0.5
    slopes = jnp.exp2(-8.0 * (jnp.arange(H, dtype=jnp.float32) + 1.0) / H)
    kpos = jnp.arange(S)

    def block(i):
        start = i * Q_BLOCK
        qb = lax.dynamic_slice_in_dim(q, start, Q_BLOCK, axis=3)
        qpos = start + jnp.arange(Q_BLOCK)
        dist = (qpos[:, None] - kpos[None, :]).astype(jnp.float32)
        bias = -slopes[:, None, None] * dist
        s = jnp.einsum('bhmqd,bhmkd->bhmqk', qb, k) * scale + bias[None, :, None]
        s = jnp.where(dist >= 0, s, -jnp.inf)
        p = jax.nn.softmax(s, axis=-1)
        a = p[:, :, 0] - lam * p[:, :, 1]
        return jnp.einsum('bhqk,bhkd->bhqd', a, v)

    o = lax.map(block, jnp.arange(nb))
    return o.transpose(1, 0, 3, 2, 4).reshape(B, S, H, dv)


def setup_inputs(seed: int = 0) -> dict:
    key = jax.random.key(seed)
    ks = jax.random.split(key, 18)
    L, D, F = DEPTH, D_MODEL, D_FF
    nrm = lambda k, shape, fan_in: jax.random.normal(k, shape, jnp.float32) * fan_in ** -0.5
    return {
        "x": jax.random.normal(ks[0], (BATCH, SEQ, D), jnp.float32),
        "c": jax.random.normal(ks[1], (BATCH, D), jnp.float32),
        "w_cond": nrm(ks[2], (L, D, N_SUB * N_MOD * D), D),
        "b_cond": 0.01 * jax.random.normal(ks[3], (L, N_SUB * N_MOD * D), jnp.float32),
        "g_norm": 1.0 + 0.02 * jax.random.normal(ks[4], (L, N_SUB, D), jnp.float32),
        "w_ffn1_in": nrm(ks[5], (L, D, 2 * F), D),
        "w_ffn1_out": nrm(ks[6], (L, F, D), F),
        "w_in": nrm(ks[7], (L, D, IN_W), D),
        "w_ret_out": nrm(ks[8], (L, RET_V_W, D), RET_V_W),
        "diff_lambda": 0.1 * jax.random.normal(ks[9], (L, 4, DIFF_HEAD_DIM), jnp.float32),
        "diff_subln": 1.0 + 0.02 * jax.random.normal(ks[10], (L, DIFF_V_DIM), jnp.float32),
        "w_diff_out": nrm(ks[11], (L, DIFF_V_W, D), DIFF_V_W),
        "w_out": nrm(ks[12], (L, D, D), D),
        "w_ffn2_in": nrm(ks[13], (L, D, 2 * F), D),
        "w_ffn2_out": nrm(ks[14], (L, F, D), F),
        "g_final": 1.0 + 0.02 * jax.random.normal(ks[15], (D,), jnp.float32),
    }


def reference(x, c, w_cond, b_cond, g_norm, w_ffn1_in, w_ffn1_out, w_in, w_ret_out,
              diff_lambda, diff_subln, w_diff_out, w_out, w_ffn2_in, w_ffn2_out, g_final):
    B, S, D = x.shape
    c_act = jax.nn.silu(c)
    for l in range(DEPTH):
        mod = (c_act @ w_cond[l] + b_cond[l]).reshape(B, N_SUB, N_MOD, D)

        h = modulate(x, g_norm[l, 0], mod[:, 0, 0], mod[:, 0, 1])
        x = x + 0.5 * mod[:, 0, 2][:, None, :] * swiglu(h, w_ffn1_in[l], w_ffn1_out[l])

        h = modulate(x, g_norm[l, 1], mod[:, 1, 0], mod[:, 1, 1])
        rq, rk, rv, rg, dq, dk_, dv_, gates = jnp.split(h @ w_in[l], SPLIT_POINTS, axis=-1)

        f32 = jnp.float32
        rq = rq.reshape(B, S, RET_HEADS, RET_QK_DIM).astype(f32)
        rk = rk.reshape(B, S, RET_HEADS, RET_QK_DIM).astype(f32) * RET_QK_DIM ** -0.5
        rv = rv.reshape(B, S, RET_HEADS, RET_V_DIM).astype(f32)
        ro = retention_chunkwise(rq, rk, rv)
        mu = jnp.mean(ro, axis=-1, keepdims=True)
        var = jnp.mean(jnp.square(ro - mu), axis=-1, keepdims=True)
        ro = ((ro - mu) * lax.rsqrt(var + EPS)).reshape(B, S, RET_V_W).astype(x.dtype)
        y_ret = (jax.nn.silu(rg) * ro) @ w_ret_out[l]

        lam_init = lambda_init(l)
        lp = diff_lambda[l].astype(f32)
        lam = jnp.exp(jnp.sum(lp[0] * lp[1])) - jnp.exp(jnp.sum(lp[2] * lp[3])) + lam_init
        dq = dq.reshape(B, S, DIFF_HEADS, 2, DIFF_HEAD_DIM).transpose(0, 2, 3, 1, 4).astype(f32)
        dk_ = dk_.reshape(B, S, DIFF_HEADS, 2, DIFF_HEAD_DIM).transpose(0, 2, 3, 1, 4).astype(f32)
        dv_ = dv_.reshape(B, S, DIFF_HEADS, DIFF_V_DIM).transpose(0, 2, 1, 3).astype(f32)
        do = diff_attention(dq, dk_, dv_, lam)
        do = rmsnorm(do, diff_subln[l]) * (1.0 - lam_init)
        y_diff = do.reshape(B, S, DIFF_V_W).astype(x.dtype) @ w_diff_out[l]

        gates = jax.nn.sigmoid(gates.reshape(B, S, N_BRANCH, D))
        y = gates[:, :, 0] * y_ret + gates[:, :, 1] * y_diff
        x = x + mod[:, 1, 2][:, None, :] * (y @ w_out[l])

        h = modulate(x, g_norm[l, 2], mod[:, 2, 0], mod[:, 2, 1])
        x = x + 0.5 * mod[:, 2, 2][:, None, :] * swiglu(h, w_ffn2_in[l], w_ffn2_out[l])

    return rmsnorm(x, g_final)
```

```cpp
#include <hip/hip_runtime.h>
#include <hip/hip_cooperative_groups.h>
#include <cstdio>
#include <cstdint>
namespace cg = cooperative_groups;

#define LAS __attribute__((address_space(3)))
#define DI __device__ __forceinline__
typedef unsigned short bf16_t;
typedef short bf16x8 __attribute__((ext_vector_type(8)));
typedef float f32x4 __attribute__((ext_vector_type(4)));
typedef float f32x16 __attribute__((ext_vector_type(16)));
typedef unsigned u32x4 __attribute__((ext_vector_type(4)));
typedef unsigned u32x2 __attribute__((ext_vector_type(2)));
typedef short s16x4 __attribute__((ext_vector_type(4)));

constexpr int D = 1024, SEQ = 2048, NB = 8, M = NB * SEQ, FF = 2816, INW = 11264, NMOD = 9216;
constexpr int GB = 4, MG = GB * SEQ;
constexpr int C_RQ = 0, C_RK = 1024, C_RV = 2048, C_RG = 4096, C_DQ = 6144, C_DK = 7168, C_DV = 8192, C_GT = 9216;
constexpr float EPS = 1e-6f;
constexpr size_t MiB = 1u << 20;
constexpr size_t WS_CTL = 0, WS_MOD = 4096, WS_W1I = 1 * MiB, WS_W1O = 12 * MiB, WS_WIN = 18 * MiB, WS_WRO = 40 * MiB, WS_WDO = 44 * MiB, WS_WO = 46 * MiB,
                 WS_H = 48 * MiB, WS_BIG = 80 * MiB, WS_END = 256 * MiB;
constexpr int LDS_BYTES = 131072 + 256;

DI unsigned cvt_pk_bf16(float lo, float hi) { unsigned r; asm volatile("v_cvt_pk_bf16_f32 %0, %1, %2" : "=v"(r) : "v"(lo), "v"(hi)); return r; }
DI float bf_lo(unsigned w) { return __uint_as_float(w << 16); }
DI float bf_hi(unsigned w) { return __uint_as_float(w & 0xffff0000u); }
DI float sigmoidf_(float x) { return __builtin_amdgcn_rcpf(1.f + __expf(-x)); }
DI float siluf_(float x) { return x * sigmoidf_(x); }
DI int olane() { int l = __builtin_amdgcn_mbcnt_hi(~0u, __builtin_amdgcn_mbcnt_lo(~0u, 0u)); asm volatile("" : "+v"(l)); return l; }
DI float wave_sum(float v) {
    int l = __builtin_amdgcn_mbcnt_hi(~0u, __builtin_amdgcn_mbcnt_lo(~0u, 0u)); asm volatile("" : "+v"(l));
#pragma unroll
    for (int o = 1; o < 64; o <<= 1) v += __uint_as_float(__builtin_amdgcn_ds_bpermute((l ^ o) << 2, __float_as_uint(v)));
    return v;
}
DI float xhalf_sum(float v) { auto rr = __builtin_amdgcn_permlane32_swap(__float_as_uint(v), __float_as_uint(v), false, false); return __uint_as_float(rr[0]) + __uint_as_float(rr[1]); }
DI float xhalf_max(float v) { auto rr = __builtin_amdgcn_permlane32_swap(__float_as_uint(v), __float_as_uint(v), false, false); return fmaxf(__uint_as_float(rr[0]), __uint_as_float(rr[1])); }

namespace pg8 {
constexpr int BM = 256, BK = 64, HALF = 128, HTB = HALF * BK * 2, STAGE_BYTES = 8 * HTB, NXCD = 8, WGM = 8;
__host__ __device__ __forceinline__ int lds_byte(int r, int c) { const int st = (r >> 4) * 2 + (c >> 5), rr = r & 15, cc = c & 31, ob = rr * 64 + cc * 2; return st * 1024 + (ob ^ (((ob >> 9) & 1) << 5)); }
__host__ __device__ __forceinline__ void stage_rc(int b, int& R, int& C) { const int st = b / 1024, sb = b % 1024, swz = sb ^ (((sb >> 9) & 1) << 5); R = (st >> 1) * 16 + swz / 64; C = (st & 1) * 32 + (swz % 64) / 2; }
__host__ __device__ __forceinline__ int perm32(int rho) { const int n = rho >> 4, i = rho & 15; return 8 * (i >> 2) + 4 * n + (i & 3); }

struct Unit { int pm, pn; };
struct Gemm { const bf16_t* A; const bf16_t* Bt; int M, N, K, lda, ldb; };

struct StaticOrder {
    int nM, nN, nwg, G, c;
    __host__ __device__ void init(int M_, int N_, int G_, int c_) { nM = M_ / BM; nN = N_ / BM; nwg = nM * nN; G = G_; c = c_; }
    __host__ __device__ bool next(int i, Unit& u) const {
        const long L = (long)i * G + c; if (L >= nwg) return false;
        int wgid = (int)L; { const int q = nwg / NXCD, r = nwg % NXCD, xcd = wgid % NXCD, off = wgid / NXCD; wgid = (xcd < r ? xcd * (q + 1) : r * (q + 1) + (xcd - r) * q) + off; }
        const int nig = WGM * nN, gid = wgid / nig, fm = gid * WGM, gsz = (nM - fm) < WGM ? (nM - fm) : WGM;
        u.pm = fm + ((wgid % nig) % gsz); u.pn = (wgid % nig) / gsz; return true;
    }
};


struct EpiSwiglu {
    static constexpr bool PERM = true;
    bf16_t* U; int ldc;
    DI void operator()(const f32x4 (&acc)[2][2][4][2], const Unit& u, int wr, int wc, int fr, int fq) const {
        const int row0 = u.pm * BM + wr * 64 + fr, col0 = u.pn * 128 + wc * 32 + 8 * fq;
#pragma unroll
        for (int ai = 0; ai < 2; ++ai)
#pragma unroll
            for (int m = 0; m < 4; ++m) {
                bf16_t* rowp = U + (size_t)(row0 + ai * HALF + m * 16) * ldc + col0;
                const f32x4 a0 = acc[ai][0][m][0], a1 = acc[ai][0][m][1], b0 = acc[ai][1][m][0], b1 = acc[ai][1][m][1];
                float v[8];
#pragma unroll
                for (int i = 0; i < 4; ++i) { v[i] = siluf_(a0[i]) * b0[i]; v[4 + i] = siluf_(a1[i]) * b1[i]; }
                u32x4 w; w.x = cvt_pk_bf16(v[0], v[1]); w.y = cvt_pk_bf16(v[2], v[3]); w.z = cvt_pk_bf16(v[4], v[5]); w.w = cvt_pk_bf16(v[6], v[7]);
                *(u32x4*)rowp = w;
            }
    }
};
struct EpiResid {
    static constexpr bool PERM = false;
    const float* base; float* out; const float* gate; float coef; int b0;
    DI void operator()(const f32x4 (&acc)[2][2][4][2], const Unit& u, int wr, int wc, int fr, int fq) const {
        const int row0 = u.pm * BM + wr * 64 + fr, col0 = u.pn * BM + wc * 32 + 4 * fq;
        const float* gp = gate + (size_t)(b0 + (u.pm >> 3)) * NMOD + col0;
        f32x4 gv[2][2];
#pragma unroll
        for (int bj = 0; bj < 2; ++bj)
#pragma unroll
            for (int n = 0; n < 2; ++n) gv[bj][n] = *(const f32x4*)(gp + bj * HALF + n * 16) * coef;
#pragma unroll
        for (int ai = 0; ai < 2; ++ai)
#pragma unroll
            for (int m = 0; m < 4; ++m) {
                const size_t off = (size_t)(row0 + ai * HALF + m * 16) * D + col0;
#pragma unroll
                for (int bj = 0; bj < 2; ++bj)
#pragma unroll
                    for (int n = 0; n < 2; ++n) { const f32x4 x = *(const f32x4*)(base + off + bj * HALF + n * 16); *(f32x4*)(out + off + bj * HALF + n * 16) = x + gv[bj][n] * acc[ai][bj][m][n]; }
            }
    }
};
struct EpiProj {
    static constexpr bool PERM = true;
    bf16_t* P;
    DI void operator()(const f32x4 (&acc)[2][2][4][2], const Unit& u, int wr, int wc, int fr, int fq) const {
        const int row0 = u.pm * BM + wr * 64 + fr, col0 = u.pn * BM + wc * 32 + 8 * fq;
        const int t = u.pn >> 2; const int act = (t == 1) ? 1 : ((t == 4 || t == 5) ? 2 : ((t >= 9) ? 3 : 0));
#pragma unroll
        for (int ai = 0; ai < 2; ++ai)
#pragma unroll
            for (int m = 0; m < 4; ++m) {
                bf16_t* rowp = P + (size_t)(row0 + ai * HALF + m * 16) * INW + col0;
#pragma unroll
                for (int bj = 0; bj < 2; ++bj) {
                    f32x4 v0 = acc[ai][bj][m][0], v1 = acc[ai][bj][m][1];
                    if (act == 1) { v0 = v0 * 0.0625f; v1 = v1 * 0.0625f; }
                    else if (act == 2) {
#pragma unroll
                        for (int i = 0; i < 4; ++i) { v0[i] = siluf_(v0[i]); v1[i] = siluf_(v1[i]); } }
                    else if (act == 3) {
#pragma unroll
                        for (int i = 0; i < 4; ++i) { v0[i] = sigmoidf_(v0[i]); v1[i] = sigmoidf_(v1[i]); } }
                    u32x4 w; w.x = cvt_pk_bf16(v0[0], v0[1]); w.y = cvt_pk_bf16(v0[2], v0[3]); w.z = cvt_pk_bf16(v1[0], v1[1]); w.w = cvt_pk_bf16(v1[2], v1[3]);
                    *(u32x4*)(rowp + bj * HALF) = w;
                }
            }
    }
};
struct EpiY {
    static constexpr bool PERM = true;
    bf16_t* P; int gcol; int add;
    DI void operator()(const f32x4 (&acc)[2][2][4][2], const Unit& u, int wr, int wc, int fr, int fq) const {
        const int row0 = u.pm * BM + wr * 64 + fr, col0 = u.pn * BM + wc * 32 + 8 * fq;
#pragma unroll
        for (int ai = 0; ai < 2; ++ai)
#pragma unroll
            for (int m = 0; m < 4; ++m) {
                bf16_t* rowp = P + (size_t)(row0 + ai * HALF + m * 16) * INW + col0;
#pragma unroll
                for (int bj = 0; bj < 2; ++bj) {
                    const f32x4 v0 = acc[ai][bj][m][0], v1 = acc[ai][bj][m][1];
                    const u32x4 g = *(const u32x4*)(rowp + gcol + bj * HALF);
                    float o[8];
                    o[0] = bf_lo(g.x) * v0[0]; o[1] = bf_hi(g.x) * v0[1]; o[2] = bf_lo(g.y) * v0[2]; o[3] = bf_hi(g.y) * v0[3];
                    o[4] = bf_lo(g.z) * v1[0]; o[5] = bf_hi(g.z) * v1[1]; o[6] = bf_lo(g.w) * v1[2]; o[7] = bf_hi(g.w) * v1[3];
                    if (add) { const u32x4 y = *(const u32x4*)(rowp + bj * HALF);
                        o[0] += bf_lo(y.x); o[1] += bf_hi(y.x); o[2] += bf_lo(y.y); o[3] += bf_hi(y.y); o[4] += bf_lo(y.z); o[5] += bf_hi(y.z); o[6] += bf_lo(y.w); o[7] += bf_hi(y.w); }
                    u32x4 w; w.x = cvt_pk_bf16(o[0], o[1]); w.y = cvt_pk_bf16(o[2], o[3]); w.z = cvt_pk_bf16(o[4], o[5]); w.w = cvt_pk_bf16(o[6], o[7]);
                    *(u32x4*)(rowp + bj * HALF) = w;
                }
            }
    }
};

template <class Epi, class Sched>
DI void gemm_phase(LAS unsigned char* lds, const Gemm g, const Sched& S, const Epi& E, const int wid) {
    const int lane = olane(), tid = wid * 64 + lane, wr = wid >> 2, wc = wid & 3, fr = lane & 15, fq = lane >> 4;
    const int K = g.K, nt = K / BK;
    unsigned voffA[2], voffB[2];
#pragma unroll
    for (int i = 0; i < 2; ++i) { int R, C; stage_rc(tid * 16 + i * 8192, R, C); const int Rb = Epi::PERM ? ((R & ~31) + perm32(R & 31)) : R;
        voffA[i] = (unsigned)(R * g.lda + C) * 2u; voffB[i] = (unsigned)(Rb * g.ldb + C) * 2u; }
    const size_t kstep = (size_t)(BK * 2);
    const size_t hsA = (size_t)HALF * g.lda * 2, hsB = (size_t)HALF * g.ldb * 2;
    const size_t tsA = 2 * hsA, tsB = 2 * hsB;
    const unsigned ldsw = (unsigned)wid * 1024u;
    const int aoff = lds_byte(wr * 64 + fr, fq * 8), boff = lds_byte(wc * 32 + fr, fq * 8);
#define PG8_SA(b, h) (((b) * 2 + (h)) * HTB)
#define PG8_SB(b, h) ((4 + (b) * 2 + (h)) * HTB)
#define PG8_STAGE(bufoff, gbase, voff) do { _Pragma("unroll") for (int _i = 0; _i < 2; ++_i) \
        __builtin_amdgcn_global_load_lds((const unsigned*)((const char*)(gbase) + (voff)[_i]), (LAS unsigned*)(lds + (bufoff) + ldsw + _i * 8192), 16, 0, 0); } while (0)
#define PG8_LDA(dst, b, h) do { _Pragma("unroll") for (int m = 0; m < 4; ++m) _Pragma("unroll") for (int k = 0; k < 2; ++k) dst[m][k] = *(const LAS bf16x8*)(lds + PG8_SA(b, h) + aoff + m * 2048 + k * 1024); } while (0)
#define PG8_LDB(dst, b, h) do { _Pragma("unroll") for (int n = 0; n < 2; ++n) _Pragma("unroll") for (int k = 0; k < 2; ++k) dst[n][k] = *(const LAS bf16x8*)(lds + PG8_SB(b, h) + boff + n * 2048 + k * 1024); } while (0)
#define PG8_MMA(ai, bj, At, Bt) do { __builtin_amdgcn_s_setprio(1); _Pragma("unroll") for (int m = 0; m < 4; ++m) _Pragma("unroll") for (int n = 0; n < 2; ++n) _Pragma("unroll") for (int k = 0; k < 2; ++k) \
        acc[ai][bj][m][n] = __builtin_amdgcn_mfma_f32_16x16x32_bf16(Bt[n][k], At[m][k], acc[ai][bj][m][n], 0, 0, 0); __builtin_amdgcn_s_setprio(0); } while (0)
#define PG8_WAIT_V(n) asm volatile("s_waitcnt vmcnt(" #n ")" ::: "memory")
#define PG8_WAIT_L(n) asm volatile("s_waitcnt lgkmcnt(" #n ")" ::: "memory")
#define PG8_BAR __builtin_amdgcn_s_barrier()
#define PG8_SCHED __builtin_amdgcn_sched_barrier(0)
    Unit cur, nxt; int ui = 0;
    if (!S.next(0, cur)) return;
    f32x4 acc[2][2][4][2];
#pragma unroll
    for (int a = 0; a < 2; ++a)
#pragma unroll
        for (int b = 0; b < 2; ++b)
#pragma unroll
            for (int m = 0; m < 4; ++m)
#pragma unroll
                for (int n = 0; n < 2; ++n) acc[a][b][m][n] = (f32x4){0.f, 0.f, 0.f, 0.f};
    bf16x8 At[4][2], B0[2][2], B1[2][2];
    const char* cA = (const char*)g.A + (size_t)cur.pm * tsA; const char* cB = (const char*)g.Bt + (size_t)cur.pn * tsB;
    PG8_STAGE(PG8_SB(0, 0), cB, voffB); PG8_STAGE(PG8_SB(0, 1), cB + hsB, voffB); PG8_STAGE(PG8_SA(0, 0), cA, voffA); PG8_STAGE(PG8_SA(0, 1), cA + hsA, voffA);
    if (wr == 1) PG8_BAR;
    PG8_WAIT_V(2); PG8_BAR;
    PG8_STAGE(PG8_SB(1, 0), cB + kstep, voffB); PG8_STAGE(PG8_SA(1, 0), cA + kstep, voffA); PG8_STAGE(PG8_SB(1, 1), cB + hsB + kstep, voffB);
    PG8_WAIT_V(6); PG8_BAR;
    for (;;) {
        const bool has_next = S.next(ui + 1, nxt);
        const char* nA = has_next ? (const char*)g.A + (size_t)nxt.pm * tsA : cA; const char* nB = has_next ? (const char*)g.Bt + (size_t)nxt.pn * tsB : cB;
        for (int t = 0; t < nt; t += 2) {
            const bool last = (t == nt - 2);
            const char* a1 = cA + (size_t)(t + 1) * kstep;
            const char* a2 = last ? nA : cA + (size_t)(t + 2) * kstep; const char* b2 = last ? nB : cB + (size_t)(t + 2) * kstep;
            const char* a3 = a2 + kstep; const char* b3 = b2 + kstep;
            PG8_LDB(B0, 0, 0); PG8_LDB(B1, 0, 1); PG8_SCHED; PG8_LDA(At, 0, 0); PG8_STAGE(PG8_SA(1, 1), a1 + hsA, voffA);
            PG8_WAIT_V(8); PG8_WAIT_L(0); PG8_BAR; PG8_MMA(0, 0, At, B0); PG8_MMA(0, 1, At, B1); PG8_BAR; PG8_SCHED;
            PG8_LDA(At, 0, 1); PG8_STAGE(PG8_SB(0, 0), b2, voffB); PG8_STAGE(PG8_SB(0, 1), b2 + hsB, voffB); PG8_STAGE(PG8_SA(0, 0), a2, voffA);
            PG8_WAIT_V(8); PG8_WAIT_L(0); PG8_BAR; PG8_MMA(1, 0, At, B0); PG8_MMA(1, 1, At, B1); PG8_BAR; PG8_SCHED;
            PG8_LDB(B0, 1, 0); PG8_LDB(B1, 1, 1); PG8_SCHED; PG8_LDA(At, 1, 0); PG8_STAGE(PG8_SA(0, 1), a2 + hsA, voffA);
            PG8_WAIT_V(8); PG8_WAIT_L(0); PG8_BAR; PG8_MMA(0, 0, At, B0); PG8_MMA(0, 1, At, B1); PG8_BAR; PG8_SCHED;
            PG8_LDA(At, 1, 1); PG8_STAGE(PG8_SB(1, 0), b3, voffB); PG8_STAGE(PG8_SB(1, 1), b3 + hsB, voffB); PG8_STAGE(PG8_SA(1, 0), a3, voffA);
            PG8_WAIT_V(8); PG8_WAIT_L(0); PG8_BAR; PG8_MMA(1, 0, At, B0); PG8_MMA(1, 1, At, B1); PG8_BAR; PG8_SCHED;
        }
        if (wr == 0) PG8_BAR;
        E(acc, cur, wr, wc, fr, fq);
        if (!has_next) break;
#pragma unroll
        for (int a = 0; a < 2; ++a)
#pragma unroll
            for (int b = 0; b < 2; ++b)
#pragma unroll
                for (int m = 0; m < 4; ++m)
#pragma unroll
                    for (int n = 0; n < 2; ++n) acc[a][b][m][n] = (f32x4){0.f, 0.f, 0.f, 0.f};
        cur = nxt; cA = nA; cB = nB; ++ui;
        if (wr == 1) PG8_BAR;
    }
    PG8_WAIT_V(0);
    PG8_BAR;
#undef PG8_SA
#undef PG8_SB
#undef PG8_STAGE
#undef PG8_LDA
#undef PG8_LDB
#undef PG8_MMA
#undef PG8_WAIT_V
#undef PG8_WAIT_L
#undef PG8_BAR
#undef PG8_SCHED
}
}

namespace att {
typedef short v4i16_t __attribute__((ext_vector_type(4)));
DI int fsw(int row) { return ((row & 3) << 2) | ((row >> 2) & 3); }
DI s16x4 vtr(LAS const unsigned char* p) { return __builtin_bit_cast(s16x4, __builtin_amdgcn_ds_read_tr16_b64_v4i16((LAS v4i16_t*)p)); }
DI void dma16(const void* g, LAS unsigned char* l) { __builtin_amdgcn_global_load_lds((const unsigned*)g, (LAS unsigned*)l, 16, 0, 0); }
#define MFMA32(a, b, c) __builtin_amdgcn_mfma_f32_32x32x16_bf16((a), (b), (c), 0, 0, 0)
DI bf16x8 pack8(const f32x16& x, int s8) {
    u32x4 p; p.x = cvt_pk_bf16(x[s8 + 0], x[s8 + 1]); p.y = cvt_pk_bf16(x[s8 + 2], x[s8 + 3]); p.z = cvt_pk_bf16(x[s8 + 4], x[s8 + 5]); p.w = cvt_pk_bf16(x[s8 + 6], x[s8 + 7]);
    return __builtin_bit_cast(bf16x8, p);
}
#define WAITV0() asm volatile("s_waitcnt vmcnt(0)" ::: "memory")

DI void diff_unit(LAS unsigned char* lds, bf16_t* P, int b, int head, int qb, float lam, const float* subln, const int wid) {
    const int lane = olane(), r = lane & 31, h = lane >> 5;
    const int mp = wid >> 2, qg = wid & 3, q0 = 128 * qb + 32 * qg, iq = q0 + r;
    bf16_t* rowb = P + (size_t)b * SEQ * INW;
    bf16x8 qf[4];
    { const bf16_t* qp = rowb + (size_t)iq * INW + C_DQ + head * 128 + mp * 64 + 8 * h;
#pragma unroll
      for (int ks = 0; ks < 4; ++ks) qf[ks] = *(const bf16x8*)(qp + 16 * ks); }
    const int NT = 2 * (qb + 1);
    unsigned koff[2], voff[2];
#pragma unroll
    for (int i = 0; i < 2; ++i) { const int L = wid * 2 + i, row = 4 * L + (lane >> 4), p = lane & 15, ch = p ^ fsw(row);
        koff[i] = (unsigned)(row * INW + C_DK + head * 128 + ch * 8) * 2u; voff[i] = (unsigned)(row * INW + C_DV + head * 128 + ch * 8) * 2u; }
    const char* gb = (const char*)rowb;
    const float slope = __builtin_amdgcn_exp2f(-(float)(head + 1));
    const float c1 = 0.125f * 1.4426950408889634f, c2 = slope * 1.4426950408889634f;
    const int fr_ = fsw(r);
    int kadr[4];
#pragma unroll
    for (int ks = 0; ks < 4; ++ks) kadr[ks] = 256 * r + 16 * ((8 * mp + 2 * ks + h) ^ fr_);
    const int i16 = lane & 15, q4 = i16 >> 2, p4 = i16 & 3, gg = (lane >> 4) & 1;
    int vlow[2], ebx[4];
#pragma unroll
    for (int jh = 0; jh < 2; ++jh) vlow[jh] = 256 * (8 * jh + 4 * h + q4) + 16 * ((2 * gg + (p4 >> 1)) ^ (2 * jh + h)) + 8 * (p4 & 1);
#pragma unroll
    for (int eb = 0; eb < 4; ++eb) ebx[eb] = 64 * (eb ^ q4);
    f32x16 o[4];
#pragma unroll
    for (int eb = 0; eb < 4; ++eb) o[eb] = (f32x16){};
    float mrun = -1e30f, lrun = 0.f;
#define DIFF_DMA(t, bi) do { const char* src_ = gb + (size_t)(t) * 64 * INW * 2; _Pragma("unroll") for (int i_ = 0; i_ < 2; ++i_) { \
        dma16(src_ + koff[i_], lds + (bi) * 32768 + (wid * 2 + i_) * 1024); dma16(src_ + voff[i_], lds + (bi) * 32768 + 16384 + (wid * 2 + i_) * 1024); } } while (0)
    DIFF_DMA(0, 0);
    for (int t = 0; t < NT; ++t) {
        WAITV0(); __syncthreads();
        if (t + 1 < NT) DIFF_DMA(t + 1, (t + 1) & 1);
        if (64 * t <= q0 + 31) {
            LAS const unsigned char* Kb = lds + (t & 1) * 32768; LAS const unsigned char* Vb = Kb + 16384;
            f32x16 st[2];
#pragma unroll
            for (int kb = 0; kb < 2; ++kb) { st[kb] = (f32x16){};
#pragma unroll
                for (int ks = 0; ks < 4; ++ks) { const bf16x8 kf = *(const LAS bf16x8*)(Kb + kb * 8192 + kadr[ks]); st[kb] = MFMA32(kf, qf[ks], st[kb]); } }
            const float base = (float)(64 * t + 4 * h - iq) * c2;
            const int lim = iq - 64 * t - 4 * h;
            const bool msk = (64 * t + 63 > q0);
            float mx = -1e30f;
#pragma unroll
            for (int kb = 0; kb < 2; ++kb)
#pragma unroll
                for (int i = 0; i < 16; ++i) { const int jrel = 32 * kb + (i & 3) + 8 * (i >> 2);
                    float s = st[kb][i] * c1 + (base + c2 * (float)jrel);
                    if (msk && jrel > lim) s = -INFINITY;
                    st[kb][i] = s; mx = fmaxf(mx, s); }
            mx = xhalf_max(mx);
            const float mnew = fmaxf(mrun, mx), alpha = __builtin_amdgcn_exp2f(mrun - mnew);
            mrun = mnew;
            float ls = 0.f;
#pragma unroll
            for (int kb = 0; kb < 2; ++kb)
#pragma unroll
                for (int i = 0; i < 16; ++i) { const float p = __builtin_amdgcn_exp2f(st[kb][i] - mnew); st[kb][i] = p; ls += p; }
            lrun = lrun * alpha + ls;
#pragma unroll
            for (int eb = 0; eb < 4; ++eb) o[eb] = o[eb] * alpha;
            bf16x8 pf[4];
#pragma unroll
            for (int s = 0; s < 4; ++s) pf[s] = pack8(st[s >> 1], 8 * (s & 1));
#pragma unroll
            for (int s = 0; s < 4; ++s)
#pragma unroll
                for (int eb = 0; eb < 4; ++eb) {
                    const s16x4 lo = vtr(Vb + vlow[0] + ebx[eb] + 4096 * s), hi = vtr(Vb + vlow[1] + ebx[eb] + 4096 * s);
                    const bf16x8 vf = __builtin_shufflevector(lo, hi, 0, 1, 2, 3, 4, 5, 6, 7);
                    o[eb] = MFMA32(vf, pf[s], o[eb]);
                }
        }
    }
#undef DIFF_DMA
    { const float lt = xhalf_sum(lrun), inv = 1.f / lt;
#pragma unroll
      for (int eb = 0; eb < 4; ++eb) o[eb] = o[eb] * inv; }
    __syncthreads();
    LAS float* X = (LAS float*)(lds + qg * 16384);
    if (mp == 1) {
#pragma unroll
        for (int eb = 0; eb < 4; ++eb)
#pragma unroll
            for (int i = 0; i < 16; ++i) X[(eb * 16 + i) * 64 + lane] = o[eb][i];
    }
    __syncthreads();
    if (mp == 0) {
        float ss = 0.f;
#pragma unroll
        for (int eb = 0; eb < 4; ++eb)
#pragma unroll
            for (int i = 0; i < 16; ++i) { const float d = o[eb][i] - lam * X[(eb * 16 + i) * 64 + lane]; o[eb][i] = d; ss += d * d; }
        ss = xhalf_sum(ss);
        const float rs = __builtin_amdgcn_rsqf(ss * (1.f / 128.f) + EPS) * 0.8f;
        bf16_t* op = rowb + (size_t)iq * INW + C_DQ + head * 128 + 4 * h;
#pragma unroll
        for (int eb = 0; eb < 4; ++eb)
#pragma unroll
            for (int g4 = 0; g4 < 4; ++g4) { const int e = 32 * eb + 8 * g4; const f32x4 w = *(const f32x4*)(subln + e + 4 * h);
                u32x2 v; v.x = cvt_pk_bf16(o[eb][4 * g4 + 0] * rs * w[0], o[eb][4 * g4 + 1] * rs * w[1]); v.y = cvt_pk_bf16(o[eb][4 * g4 + 2] * rs * w[2], o[eb][4 * g4 + 3] * rs * w[3]);
                *(u32x2*)(op + e) = v; }
    }
    __syncthreads();
}

DI void ret_unit(LAS unsigned char* lds, bf16_t* P, int b, int head, int qb, const int wid) {
    const int lane = olane(), r = lane & 31, h = lane >> 5;
    const int hh = wid >> 2, qg = wid & 3, q0 = 128 * qb + 32 * qg, iq = q0 + r;
    bf16_t* rowb = P + (size_t)b * SEQ * INW;
    bf16x8 qf[8];
    { const bf16_t* qp = rowb + (size_t)iq * INW + C_RQ + head * 256 + 128 * hh + 8 * h;
#pragma unroll
      for (int ks = 0; ks < 8; ++ks) qf[ks] = *(const bf16x8*)(qp + 16 * ks); }
    const int NT = 4 * (qb + 1);
    unsigned goff[6];
#pragma unroll
    for (int i = 0; i < 6; ++i) { const int L = wid * 6 + i;
        if (L < 16) { const int row = 2 * L + (lane >> 5), pos = lane & 31, ch = (pos & 16) + ((pos & 15) ^ fsw(row)); goff[i] = (unsigned)(row * INW + C_RK + head * 256 + ch * 8) * 2u; }
        else { const int row = L - 16, ch = (lane & 48) + ((lane & 15) ^ fsw(row)); goff[i] = (unsigned)(row * INW + C_RV + head * 512 + ch * 8) * 2u; } }
    const char* gb = (const char*)rowb;
    const float lg = __builtin_amdgcn_logf(1.f - __builtin_amdgcn_exp2f(-5.f - (float)head));
    const int fr_ = fsw(r);
    const int i16 = lane & 15, q4 = i16 >> 2, p4 = i16 & 3, gg = (lane >> 4) & 1;
    int vlow[2], ebx[4];
#pragma unroll
    for (int jh = 0; jh < 2; ++jh) vlow[jh] = 1024 * (8 * jh + 4 * h + q4) + 16 * ((2 * gg + (p4 >> 1)) ^ (2 * jh + h)) + 8 * (p4 & 1) + 512 * hh;
#pragma unroll
    for (int e3 = 0; e3 < 4; ++e3) ebx[e3] = 64 * (e3 ^ q4);
    LAS float* XS = (LAS float*)(lds + 98304 + wid * 4096) + lane;
    LAS const float* XP = (LAS const float*)(lds + 98304 + (wid ^ 4) * 4096) + lane;
    f32x16 o[8];
#pragma unroll
    for (int eb = 0; eb < 8; ++eb) o[eb] = (f32x16){};
#define RET_DMA(t, bi) do { const char* src_ = gb + (size_t)(t) * 32 * INW * 2; _Pragma("unroll") for (int i_ = 0; i_ < 6; ++i_) dma16(src_ + goff[i_], lds + (bi) * 49152 + (wid * 6 + i_) * 1024); } while (0)
    RET_DMA(0, 0);
    for (int t = 0; t < NT; ++t) {
        WAITV0(); __syncthreads();
        if (t + 1 < NT) RET_DMA(t + 1, (t + 1) & 1);
        const bool live = (32 * t <= q0 + 31);
        LAS const unsigned char* Kb = lds + (t & 1) * 49152; LAS const unsigned char* Vb = Kb + 16384;
        f32x16 st = (f32x16){};
        if (live) {
#pragma unroll
            for (int ks = 0; ks < 8; ++ks) { const bf16x8 kf = *(const LAS bf16x8*)(Kb + 512 * r + 256 * hh + 16 * ((2 * ks + h) ^ fr_)); st = MFMA32(kf, qf[ks], st); }
#pragma unroll
            for (int i = 0; i < 16; ++i) XS[i * 64] = st[i];
        }
        __syncthreads();
        if (live) {
#pragma unroll
            for (int i = 0; i < 16; ++i) st[i] += XP[i * 64];
            const float dist0 = (float)(iq - 32 * t - 4 * h);
            const bool msk = (32 * t + 31 > q0);
#pragma unroll
            for (int i = 0; i < 16; ++i) { const float d = dist0 - (float)((i & 3) + 8 * (i >> 2));
                float p = st[i] * __builtin_amdgcn_exp2f(lg * d);
                if (msk && d < 0.f) p = 0.f;
                st[i] = p; }
            bf16x8 pf[2];
            pf[0] = pack8(st, 0); pf[1] = pack8(st, 8);
#pragma unroll
            for (int s = 0; s < 2; ++s)
#pragma unroll
                for (int eb = 0; eb < 8; ++eb) {
                    const int co = 256 * (eb >> 2) + 16384 * s;
                    const s16x4 lo = vtr(Vb + vlow[0] + ebx[eb & 3] + co), hi = vtr(Vb + vlow[1] + ebx[eb & 3] + co);
                    const bf16x8 vf = __builtin_shufflevector(lo, hi, 0, 1, 2, 3, 4, 5, 6, 7);
                    o[eb] = MFMA32(vf, pf[s], o[eb]);
                }
        }
    }
#undef RET_DMA
    float s1 = 0.f, s2 = 0.f;
#pragma unroll
    for (int eb = 0; eb < 8; ++eb)
#pragma unroll
        for (int i = 0; i < 16; ++i) { const float v = o[eb][i]; s1 += v; s2 += v * v; }
    s1 = xhalf_sum(s1); s2 = xhalf_sum(s2);
    __syncthreads();
    LAS float* ST = (LAS float*)lds;
    if (h == 0) { ST[(wid * 32 + r) * 2] = s1; ST[(wid * 32 + r) * 2 + 1] = s2; }
    __syncthreads();
    { const float t1 = s1 + ST[((wid ^ 4) * 32 + r) * 2], t2 = s2 + ST[((wid ^ 4) * 32 + r) * 2 + 1];
      const float mean = t1 * (1.f / 512.f); const float var = fmaxf(t2 * (1.f / 512.f) - mean * mean, 0.f);
      const float rstd = __builtin_amdgcn_rsqf(var + EPS);
      bf16_t* op = rowb + (size_t)iq * INW + C_RG + head * 512 + 256 * hh + 4 * h;
#pragma unroll
      for (int eb = 0; eb < 8; ++eb)
#pragma unroll
          for (int g4 = 0; g4 < 4; ++g4) { bf16_t* pp = op + 32 * eb + 8 * g4; const u32x2 gq = *(const u32x2*)pp;
              u32x2 v; v.x = cvt_pk_bf16((o[eb][4 * g4 + 0] - mean) * rstd * bf_lo(gq.x), (o[eb][4 * g4 + 1] - mean) * rstd * bf_hi(gq.x));
              v.y = cvt_pk_bf16((o[eb][4 * g4 + 2] - mean) * rstd * bf_lo(gq.y), (o[eb][4 * g4 + 3] - mean) * rstd * bf_hi(gq.y));
              *(u32x2*)pp = v; } }
    __syncthreads();
}
}

DI void tr_item(const float* W, int K, int N, bf16_t* WT, int mode, LAS float* scr, int item, int lane) {
    const int nblk = N / 32, kb = item / nblk, nb = item % nblk, k0 = 64 * kb, n0 = 32 * nb;
    int rowbase = n0;
    if (mode) { const int which = n0 / FF, j = n0 - which * FF; rowbase = 256 * (j / 128) + 128 * which + (j % 128); }
#pragma unroll 8
    for (int i = 0; i < 32; ++i) { const int kk = 2 * i + (lane >> 5); scr[kk * 33 + (lane & 31)] = W[(size_t)(k0 + kk) * N + n0 + (lane & 31)]; }
    asm volatile("s_waitcnt lgkmcnt(0)" ::: "memory");
    const int c = lane & 7;
#pragma unroll
    for (int j = 0; j < 4; ++j) { const int n = (lane >> 3) + 8 * j; const LAS float* s = scr + (8 * c) * 33 + n;
        u32x4 o; o.x = cvt_pk_bf16(s[0 * 33], s[1 * 33]); o.y = cvt_pk_bf16(s[2 * 33], s[3 * 33]); o.z = cvt_pk_bf16(s[4 * 33], s[5 * 33]); o.w = cvt_pk_bf16(s[6 * 33], s[7 * 33]);
        *(u32x4*)(WT + (size_t)(rowbase + n) * K + k0 + 8 * c) = o; }
    asm volatile("s_waitcnt lgkmcnt(0)" ::: "memory");
}
DI void modulate_rows(const float* X, const float* g, const float* modsub, bf16_t* H, int ngw, const int wid) {
    const int lane = olane(), gw = blockIdx.x * 8 + wid;
    for (int m = gw; m < M; m += ngw) {
        const float* shift = modsub + (size_t)(m >> 11) * NMOD; const float* scale = shift + D;
        const f32x4* xr = (const f32x4*)(X + (size_t)m * D) + lane;
        f32x4 v[4]; float ss = 0.f;
#pragma unroll
        for (int j = 0; j < 4; ++j) { v[j] = xr[64 * j]; ss += (v[j].x * v[j].x + v[j].y * v[j].y) + (v[j].z * v[j].z + v[j].w * v[j].w); }
        const float rstd = __builtin_amdgcn_rsqf(wave_sum(ss) * (1.f / D) + EPS);
#pragma unroll
        for (int j = 0; j < 4; ++j) { const int k = 4 * (lane + 64 * j);
            const f32x4 gv = *(const f32x4*)(g + k), sc = *(const f32x4*)(scale + k), sh = *(const f32x4*)(shift + k);
            const f32x4 y = (v[j] * rstd * gv) * (sc + 1.f) + sh;
            u32x2 w; w.x = cvt_pk_bf16(y.x, y.y); w.y = cvt_pk_bf16(y.z, y.w);
            *(u32x2*)(H + (size_t)m * D + k) = w; }
    }
}

struct Args { const float* in[16]; float* out; unsigned char* ws; };

__global__ void __launch_bounds__(512, 2) mega(Args a) {
    extern __shared__ __attribute__((aligned(16))) unsigned char lds_raw[];
    LAS unsigned char* lds = (LAS unsigned char*)lds_raw;
    cg::grid_group grid = cg::this_grid();
    const int wid = __builtin_amdgcn_readfirstlane((int)threadIdx.x >> 6);
    const int G = gridDim.x, ngw = G * 8;
    unsigned char* ws = a.ws;
    const float* x_in = a.in[0];
    float* out = a.out;
    float* mod = (float*)(ws + WS_MOD);
    unsigned* ctl = (unsigned*)(ws + WS_CTL);
    bf16_t* W1I = (bf16_t*)(ws + WS_W1I); bf16_t* W1O = (bf16_t*)(ws + WS_W1O); bf16_t* WIN = (bf16_t*)(ws + WS_WIN);
    bf16_t* WRO = (bf16_t*)(ws + WS_WRO); bf16_t* WDO = (bf16_t*)(ws + WS_WDO); bf16_t* WO = (bf16_t*)(ws + WS_WO);
    bf16_t* H = (bf16_t*)(ws + WS_H); bf16_t* BIG = (bf16_t*)(ws + WS_BIG);
    LAS unsigned* sflag = (LAS unsigned*)(lds + 131072);

    for (int item = blockIdx.x; item < NMOD / 64; item += G) {
        const int lane = olane(), tid = wid * 64 + lane;
        LAS float* cs = (LAS float*)lds; LAS float* red = (LAS float*)(lds + 32768);
        for (int i = tid; i < NB * D; i += 512) cs[i] = siluf_(a.in[1][i]);
        __syncthreads();
        const int col = item * 64 + lane, k0 = wid * 128;
        float acc[8];
#pragma unroll
        for (int b = 0; b < 8; ++b) acc[b] = 0.f;
        const float* wp = a.in[2] + (size_t)k0 * NMOD + col;
#pragma unroll 8
        for (int k = 0; k < 128; ++k) { const float w = wp[(size_t)k * NMOD];
#pragma unroll
            for (int b = 0; b < 8; ++b) acc[b] += cs[b * D + k0 + k] * w; }
#pragma unroll
        for (int b = 0; b < 8; ++b) red[(wid * 8 + b) * 64 + lane] = acc[b];
        __syncthreads();
        { float s = 0.f;
#pragma unroll
          for (int w = 0; w < 8; ++w) s += red[(w * 8 + wid) * 64 + lane];
          mod[(size_t)wid * NMOD + col] = s + a.in[3][col]; }
        __syncthreads();
    }
    {
        const int lane = olane(), gw = blockIdx.x * 8 + wid;
        LAS float* scr = (LAS float*)(lds + wid * 16384);
        constexpr int I_FI = (D / 64) * (2 * FF / 32), I_FO = (FF / 64) * (D / 32), I_IN = (D / 64) * (INW / 32), I_RO = (2048 / 64) * (D / 32), I_DO = (D / 64) * (D / 32);
        constexpr int NIT = I_FI + I_FO + I_IN + I_RO + 2 * I_DO;
        for (int it = gw; it < NIT; it += ngw) {
            int r = it;
            if (r < I_FI) { tr_item(a.in[5], D, 2 * FF, W1I, 1, scr, r, lane); continue; } r -= I_FI;
            if (r < I_FO) { tr_item(a.in[6], FF, D, W1O, 0, scr, r, lane); continue; } r -= I_FO;
            if (r < I_IN) { tr_item(a.in[7], D, INW, WIN, 0, scr, r, lane); continue; } r -= I_IN;
            if (r < I_RO) { tr_item(a.in[8], 2048, D, WRO, 0, scr, r, lane); continue; } r -= I_RO;
            if (r < I_DO) { tr_item(a.in[11], D, D, WDO, 0, scr, r, lane); continue; } r -= I_DO;
            tr_item(a.in[12], D, D, WO, 0, scr, r, lane);
        }
    }
    grid.sync();

#pragma unroll 1
    for (int stage = 0; stage < 2; ++stage) {
        modulate_rows(stage == 0 ? x_in : out, a.in[4] + (stage == 0 ? 0 : 2 * D), mod + (stage == 0 ? 0 : 2 * 3 * D), H, ngw, wid);
        grid.sync();
        { pg8::Gemm g{H, W1I, M, 2 * FF, D, D, D}; pg8::StaticOrder S; S.init(M, 2 * FF, G, (int)blockIdx.x);
          pg8::EpiSwiglu E{BIG, FF};
          pg8::gemm_phase<pg8::EpiSwiglu, pg8::StaticOrder>(lds, g, S, E, wid); }
        grid.sync();
        { pg8::Gemm g{BIG, W1O, M, D, FF, FF, FF}; pg8::StaticOrder S; S.init(M, D, G, (int)blockIdx.x);
          pg8::EpiResid E{stage == 0 ? x_in : out, out, mod + (stage == 0 ? 0 : 2 * 3 * D) + 2 * D, 0.5f, 0};
          pg8::gemm_phase<pg8::EpiResid, pg8::StaticOrder>(lds, g, S, E, wid); }
        grid.sync();
        if (stage == 1) break;

        modulate_rows(out, a.in[4] + D, mod + 3 * D, H, ngw, wid);
        {
            const int lane = olane(), gw = blockIdx.x * 8 + wid;
            LAS float* scr = (LAS float*)(lds + wid * 16384);
            constexpr int I_FI = (D / 64) * (2 * FF / 32), I_FO = (FF / 64) * (D / 32);
            for (int it = gw; it < I_FI + I_FO; it += ngw) {
                if (it < I_FI) tr_item(a.in[13], D, 2 * FF, W1I, 1, scr, it, lane);
                else tr_item(a.in[14], FF, D, W1O, 0, scr, it - I_FI, lane);
            }
        }
        grid.sync();
        { const int lane = olane(); const float* lp = a.in[9]; const float s01 = wave_sum(lp[lane] * lp[64 + lane]), s23 = wave_sum(lp[128 + lane] * lp[192 + lane]);
          if (wid == 0 && lane == 0) ((LAS float*)sflag)[1] = __expf(s01) - __expf(s23) + 0.2f; }
#pragma unroll 1
        for (int grp = 0; grp < NB / GB; ++grp) {
            { pg8::Gemm g{H + (size_t)grp * MG * D, WIN, MG, INW, D, D, D}; pg8::StaticOrder S; S.init(MG, INW, G, (int)blockIdx.x);
              pg8::EpiProj E{BIG};
              pg8::gemm_phase<pg8::EpiProj, pg8::StaticOrder>(lds, g, S, E, wid); }
            grid.sync();
            for (;;) {
                if (wid == 0 && olane() == 0) sflag[0] = atomicAdd(ctl + 64 * grp, 1u);
                __syncthreads();
                const int u = (int)sflag[0];
                __syncthreads();
                if (u >= 256 + 512) break;
                if (u < 256) { const int qb = 15 - (u >> 4), bh = u & 15; att::ret_unit(lds, BIG, bh >> 2, bh & 3, qb, wid); }
                else { const int j = u - 256, qb = 15 - (j >> 5), bh = j & 31; att::diff_unit(lds, BIG, bh >> 3, bh & 7, qb, ((LAS float*)sflag)[1], a.in[10], wid); }
            }
            grid.sync();
            { pg8::StaticOrder S; S.init(MG, D, G, (int)blockIdx.x);
              { pg8::Gemm g{BIG + C_RG, WRO, MG, D, 2048, INW, 2048}; pg8::EpiY E{BIG, C_GT, 0}; pg8::gemm_phase<pg8::EpiY, pg8::StaticOrder>(lds, g, S, E, wid); }
              { pg8::Gemm g{BIG + C_DQ, WDO, MG, D, D, INW, D}; pg8::EpiY E{BIG, C_GT + D, 1}; pg8::gemm_phase<pg8::EpiY, pg8::StaticOrder>(lds, g, S, E, wid); } }
            grid.sync();
            { pg8::Gemm g{BIG, WO, MG, D, D, INW, D}; pg8::StaticOrder S; S.init(MG, D, G, (int)blockIdx.x);
              float* o2 = out + (size_t)grp * MG * D;
              pg8::EpiResid E{o2, o2, mod + 3 * D + 2 * D, 1.0f, grp * GB};
              pg8::gemm_phase<pg8::EpiResid, pg8::StaticOrder>(lds, g, S, E, wid); }
            grid.sync();
        }
    }
    const int lane = olane(), gw = blockIdx.x * 8 + wid;
    for (int m = gw; m < M; m += ngw) {
        f32x4* xr = (f32x4*)(out + (size_t)m * D) + lane;
        f32x4 v[4]; float ss = 0.f;
#pragma unroll
        for (int j = 0; j < 4; ++j) { v[j] = xr[64 * j]; ss += (v[j].x * v[j].x + v[j].y * v[j].y) + (v[j].z * v[j].z + v[j].w * v[j].w); }
        const float rstd = __builtin_amdgcn_rsqf(wave_sum(ss) * (1.f / D) + EPS);
#pragma unroll
        for (int j = 0; j < 4; ++j) { const f32x4 gv = *(const f32x4*)(a.in[15] + 4 * (lane + 64 * j)); xr[64 * j] = v[j] * rstd * gv; }
    }
}

extern "C" void kernel_launch(void* const* d_in, const int* in_sizes, int n_in, void* d_out, int out_size, void* d_ws, size_t ws_size, hipStream_t stream) {
    static int grid = 0;
    if (grid == 0) {
        if (n_in != 16 || out_size != M * D || ws_size < WS_END) { fprintf(stderr, "kernel_launch: unexpected problem (n_in %d out %d ws %zu)\n", n_in, out_size, ws_size); grid = -1; return; }
        int dev = 0, cus = 0, per_cu = 0;
        hipGetDevice(&dev); hipDeviceGetAttribute(&cus, hipDeviceAttributeMultiprocessorCount, dev);
        hipFuncSetAttribute((const void*)mega, hipFuncAttributeMaxDynamicSharedMemorySize, LDS_BYTES);
        hipOccupancyMaxActiveBlocksPerMultiprocessor(&per_cu, (const void*)mega, 512, LDS_BYTES);
        if (per_cu < 1) { fprintf(stderr, "kernel_launch: occupancy query says %d blocks per CU\n", per_cu); per_cu = 1; }
        grid = cus * 1;
    }
    if (grid < 0) return;
    hipMemsetAsync((char*)d_ws + WS_CTL, 0, 4096, stream);
    Args a{};
    for (int i = 0; i < 16; ++i) a.in[i] = (const float*)d_in[i];
    a.out = (float*)d_out; a.ws = (unsigned char*)d_ws;
    void* args[] = {&a};
    hipError_t e = hipLaunchCooperativeKernel((const void*)mega, dim3(grid), dim3(512), args, LDS_BYTES, stream);
    if (e != hipSuccess) fprintf(stderr, "cooperative launch failed: %s (grid %d)\n", hipGetErrorString(e), grid);
}
```

```cpp
#include <hip/hip_runtime.h>
#include <hip/hip_cooperative_groups.h>
#include <cstdio>
#include <cstdint>
namespace cg = cooperative_groups;

#define LAS __attribute__((address_space(3)))
#define DI __device__ __forceinline__
typedef unsigned short bf16_t;
typedef short bf16x8 __attribute__((ext_vector_type(8)));
typedef float f32x4 __attribute__((ext_vector_type(4)));
typedef float f32x16 __attribute__((ext_vector_type(16)));
typedef unsigned u32x4 __attribute__((ext_vector_type(4)));
typedef unsigned u32x2 __attribute__((ext_vector_type(2)));
typedef short s16x4 __attribute__((ext_vector_type(4)));

constexpr int D = 1024, SEQ = 2048, NB = 8, M = NB * SEQ, FF = 2816, INW = 11264, NMOD = 9216;
constexpr int GB = 4, MG = GB * SEQ;
constexpr int C_RQ = 0, C_RK = 1024, C_RV = 2048, C_RG = 4096, C_DQ = 6144, C_DK = 7168, C_DV = 8192, C_GT = 9216;
constexpr float EPS = 1e-6f;
constexpr size_t MiB = 1u << 20;
constexpr size_t WS_CTL = 0, WS_BAR = 16384, CTL_ZERO = 65536, WS_MOD = 65536, WS_W1I = 1 * MiB, WS_W1O = 12 * MiB, WS_WIN = 18 * MiB, WS_WRO = 40 * MiB, WS_WDO = 44 * MiB, WS_WO = 46 * MiB,
                 WS_H = 48 * MiB, WS_BIG = 80 * MiB, WS_END = 256 * MiB;
constexpr int LDS_BYTES = 131072 + 256;

DI unsigned cvt_pk_bf16(float lo, float hi) { unsigned r; asm volatile("v_cvt_pk_bf16_f32 %0, %1, %2" : "=v"(r) : "v"(lo), "v"(hi)); return r; }
DI float bf_lo(unsigned w) { return __uint_as_float(w << 16); }
DI float bf_hi(unsigned w) { return __uint_as_float(w & 0xffff0000u); }
DI float sigmoidf_(float x) { return __builtin_amdgcn_rcpf(1.f + __expf(-x)); }
DI float siluf_(float x) { return x * sigmoidf_(x); }
DI int olane() { int l = __builtin_amdgcn_mbcnt_hi(~0u, __builtin_amdgcn_mbcnt_lo(~0u, 0u)); asm volatile("" : "+v"(l)); return l; }
DI float wave_sum(float v) {
    int l = __builtin_amdgcn_mbcnt_hi(~0u, __builtin_amdgcn_mbcnt_lo(~0u, 0u)); asm volatile("" : "+v"(l));
#pragma unroll
    for (int o = 1; o < 64; o <<= 1) v += __uint_as_float(__builtin_amdgcn_ds_bpermute((l ^ o) << 2, __float_as_uint(v)));
    return v;
}
DI float xhalf_sum(float v) { auto rr = __builtin_amdgcn_permlane32_swap(__float_as_uint(v), __float_as_uint(v), false, false); return __uint_as_float(rr[0]) + __uint_as_float(rr[1]); }
DI float xhalf_max(float v) { auto rr = __builtin_amdgcn_permlane32_swap(__float_as_uint(v), __float_as_uint(v), false, false); return fmaxf(__uint_as_float(rr[0]), __uint_as_float(rr[1])); }

namespace pg8 {
constexpr int BM = 256, BK = 64, HALF = 128, HTB = HALF * BK * 2, STAGE_BYTES = 8 * HTB, NXCD = 8, WGM = 8;
__host__ __device__ __forceinline__ int lds_byte(int r, int c) { const int st = (r >> 4) * 2 + (c >> 5), rr = r & 15, cc = c & 31, ob = rr * 64 + cc * 2; return st * 1024 + (ob ^ (((ob >> 9) & 1) << 5)); }
__host__ __device__ __forceinline__ void stage_rc(int b, int& R, int& C) { const int st = b / 1024, sb = b % 1024, swz = sb ^ (((sb >> 9) & 1) << 5); R = (st >> 1) * 16 + swz / 64; C = (st & 1) * 32 + (swz % 64) / 2; }
__host__ __device__ __forceinline__ int perm32(int rho) { const int n = rho >> 4, i = rho & 15; return 8 * (i >> 2) + 4 * n + (i & 3); }

struct Unit { int pm, pn; };
struct Gemm { const bf16_t* A; const bf16_t* Bt; int M, N, K, lda, ldb; };

struct StaticOrder {
    int nM, nN, nwg, G, c;
    __host__ __device__ void init(int M_, int N_, int G_, int c_) { nM = M_ / BM; nN = N_ / BM; nwg = nM * nN; G = G_; c = c_; }
    __host__ __device__ bool next(int i, Unit& u) const {
        const long L = (long)i * G + c; if (L >= nwg) return false;
        int wgid = (int)L; { const int q = nwg / NXCD, r = nwg % NXCD, xcd = wgid % NXCD, off = wgid / NXCD; wgid = (xcd < r ? xcd * (q + 1) : r * (q + 1) + (xcd - r) * q) + off; }
        const int nig = WGM * nN, gid = wgid / nig, fm = gid * WGM, gsz = (nM - fm) < WGM ? (nM - fm) : WGM;
        u.pm = fm + ((wgid % nig) % gsz); u.pn = (wgid % nig) / gsz; return true;
    }
};


struct EpiSwiglu {
    static constexpr bool PERM = true;
    bf16_t* U; int ldc;
    DI void operator()(const f32x4 (&acc)[2][2][4][2], const Unit& u, int wr, int wc, int fr, int fq) const {
        const int row0 = u.pm * BM + wr * 64 + fr, col0 = u.pn * 128 + wc * 32 + 8 * fq;
#pragma unroll
        for (int ai = 0; ai < 2; ++ai)
#pragma unroll
            for (int m = 0; m < 4; ++m) {
                bf16_t* rowp = U + (size_t)(row0 + ai * HALF + m * 16) * ldc + col0;
                const f32x4 a0 = acc[ai][0][m][0], a1 = acc[ai][0][m][1], b0 = acc[ai][1][m][0], b1 = acc[ai][1][m][1];
                float v[8];
#pragma unroll
                for (int i = 0; i < 4; ++i) { v[i] = siluf_(a0[i]) * b0[i]; v[4 + i] = siluf_(a1[i]) * b1[i]; }
                u32x4 w; w.x = cvt_pk_bf16(v[0], v[1]); w.y = cvt_pk_bf16(v[2], v[3]); w.z = cvt_pk_bf16(v[4], v[5]); w.w = cvt_pk_bf16(v[6], v[7]);
                *(u32x4*)rowp = w;
            }
    }
};
struct EpiResid {
    static constexpr bool PERM = false;
    const float* base; float* out; const float* gate; float coef; int b0;
    DI void operator()(const f32x4 (&acc)[2][2][4][2], const Unit& u, int wr, int wc, int fr, int fq) const {
        const int row0 = u.pm * BM + wr * 64 + fr, col0 = u.pn * BM + wc * 32 + 4 * fq;
        const float* gp = gate + (size_t)(b0 + (u.pm >> 3)) * NMOD + col0;
        f32x4 gv[2][2];
#pragma unroll
        for (int bj = 0; bj < 2; ++bj)
#pragma unroll
            for (int n = 0; n < 2; ++n) gv[bj][n] = *(const f32x4*)(gp + bj * HALF + n * 16) * coef;
#pragma unroll
        for (int ai = 0; ai < 2; ++ai)
#pragma unroll
            for (int m = 0; m < 4; ++m) {
                const size_t off = (size_t)(row0 + ai * HALF + m * 16) * D + col0;
#pragma unroll
                for (int bj = 0; bj < 2; ++bj)
#pragma unroll
                    for (int n = 0; n < 2; ++n) { const f32x4 x = *(const f32x4*)(base + off + bj * HALF + n * 16); *(f32x4*)(out + off + bj * HALF + n * 16) = x + gv[bj][n] * acc[ai][bj][m][n]; }
            }
    }
};
struct EpiProj {
    static constexpr bool PERM = true;
    bf16_t* P;
    DI void operator()(const f32x4 (&acc)[2][2][4][2], const Unit& u, int wr, int wc, int fr, int fq) const {
        const int row0 = u.pm * BM + wr * 64 + fr, col0 = u.pn * BM + wc * 32 + 8 * fq;
        const int t = u.pn >> 2; const int act = (t == 1) ? 1 : ((t == 4 || t == 5) ? 2 : ((t >= 9) ? 3 : 0));
#pragma unroll
        for (int ai = 0; ai < 2; ++ai)
#pragma unroll
            for (int m = 0; m < 4; ++m) {
                bf16_t* rowp = P + (size_t)(row0 + ai * HALF + m * 16) * INW + col0;
#pragma unroll
                for (int bj = 0; bj < 2; ++bj) {
                    f32x4 v0 = acc[ai][bj][m][0], v1 = acc[ai][bj][m][1];
                    if (act == 1) { v0 = v0 * 0.0625f; v1 = v1 * 0.0625f; }
                    else if (act == 2) {
#pragma unroll
                        for (int i = 0; i < 4; ++i) { v0[i] = siluf_(v0[i]); v1[i] = siluf_(v1[i]); } }
                    else if (act == 3) {
#pragma unroll
                        for (int i = 0; i < 4; ++i) { v0[i] = sigmoidf_(v0[i]); v1[i] = sigmoidf_(v1[i]); } }
                    u32x4 w; w.x = cvt_pk_bf16(v0[0], v0[1]); w.y = cvt_pk_bf16(v0[2], v0[3]); w.z = cvt_pk_bf16(v1[0], v1[1]); w.w = cvt_pk_bf16(v1[2], v1[3]);
                    *(u32x4*)(rowp + bj * HALF) = w;
                }
            }
    }
};
struct EpiY {
    static constexpr bool PERM = true;
    bf16_t* P; int gcol; int add;
    DI void operator()(const f32x4 (&acc)[2][2][4][2], const Unit& u, int wr, int wc, int fr, int fq) const {
        const int row0 = u.pm * BM + wr * 64 + fr, col0 = u.pn * BM + wc * 32 + 8 * fq;
#pragma unroll
        for (int ai = 0; ai < 2; ++ai)
#pragma unroll
            for (int m = 0; m < 4; ++m) {
                bf16_t* rowp = P + (size_t)(row0 + ai * HALF + m * 16) * INW + col0;
#pragma unroll
                for (int bj = 0; bj < 2; ++bj) {
                    const f32x4 v0 = acc[ai][bj][m][0], v1 = acc[ai][bj][m][1];
                    const u32x4 g = *(const u32x4*)(rowp + gcol + bj * HALF);
                    float o[8];
                    o[0] = bf_lo(g.x) * v0[0]; o[1] = bf_hi(g.x) * v0[1]; o[2] = bf_lo(g.y) * v0[2]; o[3] = bf_hi(g.y) * v0[3];
                    o[4] = bf_lo(g.z) * v1[0]; o[5] = bf_hi(g.z) * v1[1]; o[6] = bf_lo(g.w) * v1[2]; o[7] = bf_hi(g.w) * v1[3];
                    if (add) { const u32x4 y = *(const u32x4*)(rowp + bj * HALF);
                        o[0] += bf_lo(y.x); o[1] += bf_hi(y.x); o[2] += bf_lo(y.y); o[3] += bf_hi(y.y); o[4] += bf_lo(y.z); o[5] += bf_hi(y.z); o[6] += bf_lo(y.w); o[7] += bf_hi(y.w); }
                    u32x4 w; w.x = cvt_pk_bf16(o[0], o[1]); w.y = cvt_pk_bf16(o[2], o[3]); w.z = cvt_pk_bf16(o[4], o[5]); w.w = cvt_pk_bf16(o[6], o[7]);
                    *(u32x4*)(rowp + bj * HALF) = w;
                }
            }
    }
};

template <class Epi, class Sched>
DI void gemm_phase(LAS unsigned char* lds, const Gemm g, const Sched& S, const Epi& E, const int wid) {
    const int lane = olane(), tid = wid * 64 + lane, wr = wid >> 2, wc = wid & 3, fr = lane & 15, fq = lane >> 4;
    const int K = g.K, nt = K / BK;
    unsigned voffA[2], voffB[2];
#pragma unroll
    for (int i = 0; i < 2; ++i) { int R, C; stage_rc(tid * 16 + i * 8192, R, C); const int Rb = Epi::PERM ? ((R & ~31) + perm32(R & 31)) : R;
        voffA[i] = (unsigned)(R * g.lda + C) * 2u; voffB[i] = (unsigned)(Rb * g.ldb + C) * 2u; }
    const size_t kstep = (size_t)(BK * 2);
    const size_t hsA = (size_t)HALF * g.lda * 2, hsB = (size_t)HALF * g.ldb * 2;
    const size_t tsA = 2 * hsA, tsB = 2 * hsB;
    const unsigned ldsw = (unsigned)wid * 1024u;
    const int aoff = lds_byte(wr * 64 + fr, fq * 8), boff = lds_byte(wc * 32 + fr, fq * 8);
#define PG8_SA(b, h) (((b) * 2 + (h)) * HTB)
#define PG8_SB(b, h) ((4 + (b) * 2 + (h)) * HTB)
#define PG8_STAGE(bufoff, gbase, voff) do { _Pragma("unroll") for (int _i = 0; _i < 2; ++_i) \
        __builtin_amdgcn_global_load_lds((const unsigned*)((const char*)(gbase) + (voff)[_i]), (LAS unsigned*)(lds + (bufoff) + ldsw + _i * 8192), 16, 0, 0); } while (0)
#define PG8_LDA(dst, b, h) do { _Pragma("unroll") for (int m = 0; m < 4; ++m) _Pragma("unroll") for (int k = 0; k < 2; ++k) dst[m][k] = *(const LAS bf16x8*)(lds + PG8_SA(b, h) + aoff + m * 2048 + k * 1024); } while (0)
#define PG8_LDB(dst, b, h) do { _Pragma("unroll") for (int n = 0; n < 2; ++n) _Pragma("unroll") for (int k = 0; k < 2; ++k) dst[n][k] = *(const LAS bf16x8*)(lds + PG8_SB(b, h) + boff + n * 2048 + k * 1024); } while (0)
#define PG8_MMA(ai, bj, At, Bt) do { __builtin_amdgcn_s_setprio(1); _Pragma("unroll") for (int m = 0; m < 4; ++m) _Pragma("unroll") for (int n = 0; n < 2; ++n) _Pragma("unroll") for (int k = 0; k < 2; ++k) \
        acc[ai][bj][m][n] = __builtin_amdgcn_mfma_f32_16x16x32_bf16(Bt[n][k], At[m][k], acc[ai][bj][m][n], 0, 0, 0); __builtin_amdgcn_s_setprio(0); } while (0)
#define PG8_WAIT_V(n) asm volatile("s_waitcnt vmcnt(" #n ")" ::: "memory")
#define PG8_WAIT_L(n) asm volatile("s_waitcnt lgkmcnt(" #n ")" ::: "memory")
#define PG8_BAR __builtin_amdgcn_s_barrier()
#define PG8_SCHED __builtin_amdgcn_sched_barrier(0)
    Unit cur, nxt; int ui = 0;
    if (!S.next(0, cur)) return;
    f32x4 acc[2][2][4][2];
#pragma unroll
    for (int a = 0; a < 2; ++a)
#pragma unroll
        for (int b = 0; b < 2; ++b)
#pragma unroll
            for (int m = 0; m < 4; ++m)
#pragma unroll
                for (int n = 0; n < 2; ++n) acc[a][b][m][n] = (f32x4){0.f, 0.f, 0.f, 0.f};
    bf16x8 At[4][2], B0[2][2], B1[2][2];
    const char* cA = (const char*)g.A + (size_t)cur.pm * tsA; const char* cB = (const char*)g.Bt + (size_t)cur.pn * tsB;
    PG8_STAGE(PG8_SB(0, 0), cB, voffB); PG8_STAGE(PG8_SB(0, 1), cB + hsB, voffB); PG8_STAGE(PG8_SA(0, 0), cA, voffA); PG8_STAGE(PG8_SA(0, 1), cA + hsA, voffA);
    if (wr == 1) PG8_BAR;
    PG8_WAIT_V(2); PG8_BAR;
    PG8_STAGE(PG8_SB(1, 0), cB + kstep, voffB); PG8_STAGE(PG8_SA(1, 0), cA + kstep, voffA); PG8_STAGE(PG8_SB(1, 1), cB + hsB + kstep, voffB);
    PG8_WAIT_V(6); PG8_BAR;
    for (;;) {
        const bool has_next = S.next(ui + 1, nxt);
        const char* nA = has_next ? (const char*)g.A + (size_t)nxt.pm * tsA : cA; const char* nB = has_next ? (const char*)g.Bt + (size_t)nxt.pn * tsB : cB;
        for (int t = 0; t < nt; t += 2) {
            const bool last = (t == nt - 2);
            const char* a1 = cA + (size_t)(t + 1) * kstep;
            const char* a2 = last ? nA : cA + (size_t)(t + 2) * kstep; const char* b2 = last ? nB : cB + (size_t)(t + 2) * kstep;
            const char* a3 = a2 + kstep; const char* b3 = b2 + kstep;
            PG8_LDB(B0, 0, 0); PG8_LDB(B1, 0, 1); PG8_SCHED; PG8_LDA(At, 0, 0); PG8_STAGE(PG8_SA(1, 1), a1 + hsA, voffA);
            PG8_WAIT_V(8); PG8_WAIT_L(0); PG8_BAR; PG8_MMA(0, 0, At, B0); PG8_MMA(0, 1, At, B1); PG8_BAR; PG8_SCHED;
            PG8_LDA(At, 0, 1); PG8_STAGE(PG8_SB(0, 0), b2, voffB); PG8_STAGE(PG8_SB(0, 1), b2 + hsB, voffB); PG8_STAGE(PG8_SA(0, 0), a2, voffA);
            PG8_WAIT_V(8); PG8_WAIT_L(0); PG8_BAR; PG8_MMA(1, 0, At, B0); PG8_MMA(1, 1, At, B1); PG8_BAR; PG8_SCHED;
            PG8_LDB(B0, 1, 0); PG8_LDB(B1, 1, 1); PG8_SCHED; PG8_LDA(At, 1, 0); PG8_STAGE(PG8_SA(0, 1), a2 + hsA, voffA);
            PG8_WAIT_V(8); PG8_WAIT_L(0); PG8_BAR; PG8_MMA(0, 0, At, B0); PG8_MMA(0, 1, At, B1); PG8_BAR; PG8_SCHED;
            PG8_LDA(At, 1, 1); PG8_STAGE(PG8_SB(1, 0), b3, voffB); PG8_STAGE(PG8_SB(1, 1), b3 + hsB, voffB); PG8_STAGE(PG8_SA(1, 0), a3, voffA);
            PG8_WAIT_V(8); PG8_WAIT_L(0); PG8_BAR; PG8_MMA(1, 0, At, B0); PG8_MMA(1, 1, At, B1); PG8_BAR; PG8_SCHED;
        }
        if (wr == 0) PG8_BAR;
        E(acc, cur, wr, wc, fr, fq);
        if (!has_next) break;
#pragma unroll
        for (int a = 0; a < 2; ++a)
#pragma unroll
            for (int b = 0; b < 2; ++b)
#pragma unroll
                for (int m = 0; m < 4; ++m)
#pragma unroll
                    for (int n = 0; n < 2; ++n) acc[a][b][m][n] = (f32x4){0.f, 0.f, 0.f, 0.f};
        cur = nxt; cA = nA; cB = nB; ++ui;
        if (wr == 1) PG8_BAR;
    }
    PG8_WAIT_V(0);
    PG8_BAR;
#undef PG8_SA
#undef PG8_SB
#undef PG8_STAGE
#undef PG8_LDA
#undef PG8_LDB
#undef PG8_MMA
#undef PG8_WAIT_V
#undef PG8_WAIT_L
#undef PG8_BAR
#undef PG8_SCHED
}
}

namespace att {
typedef short v4i16_t __attribute__((ext_vector_type(4)));
DI int fsw(int row) { return ((row & 3) << 2) | ((row >> 2) & 3); }
DI s16x4 vtr(LAS const unsigned char* p) { return __builtin_bit_cast(s16x4, __builtin_amdgcn_ds_read_tr16_b64_v4i16((LAS v4i16_t*)p)); }
DI void dma16(const void* g, LAS unsigned char* l) { __builtin_amdgcn_global_load_lds((const unsigned*)g, (LAS unsigned*)l, 16, 0, 0); }
#define MFMA32(a, b, c) __builtin_amdgcn_mfma_f32_32x32x16_bf16((a), (b), (c), 0, 0, 0)
DI bf16x8 pack8(const f32x16& x, int s8) {
    u32x4 p; p.x = cvt_pk_bf16(x[s8 + 0], x[s8 + 1]); p.y = cvt_pk_bf16(x[s8 + 2], x[s8 + 3]); p.z = cvt_pk_bf16(x[s8 + 4], x[s8 + 5]); p.w = cvt_pk_bf16(x[s8 + 6], x[s8 + 7]);
    return __builtin_bit_cast(bf16x8, p);
}
#define WAITV0() asm volatile("s_waitcnt vmcnt(0)" ::: "memory")

DI void diff_unit(LAS unsigned char* lds, bf16_t* P, int b, int head, int qb, float lam, const float* subln, const int wid) {
    const int lane = olane(), r = lane & 31, h = lane >> 5;
    const int mp = wid >> 2, qg = wid & 3, q0 = 128 * qb + 32 * qg, iq = q0 + r;
    bf16_t* rowb = P + (size_t)b * SEQ * INW;
    bf16x8 qf[4];
    { const bf16_t* qp = rowb + (size_t)iq * INW + C_DQ + head * 128 + mp * 64 + 8 * h;
#pragma unroll
      for (int ks = 0; ks < 4; ++ks) qf[ks] = *(const bf16x8*)(qp + 16 * ks); }
    const int NT = 2 * (qb + 1);
    unsigned koff[2], voff[2];
#pragma unroll
    for (int i = 0; i < 2; ++i) { const int L = wid * 2 + i, row = 4 * L + (lane >> 4), p = lane & 15, ch = p ^ fsw(row);
        koff[i] = (unsigned)(row * INW + C_DK + head * 128 + ch * 8) * 2u; voff[i] = (unsigned)(row * INW + C_DV + head * 128 + ch * 8) * 2u; }
    const char* gb = (const char*)rowb;
    const float slope = __builtin_amdgcn_exp2f(-(float)(head + 1));
    const float c1 = 0.125f * 1.4426950408889634f, c2 = slope * 1.4426950408889634f;
    const int fr_ = fsw(r);
    int kadr[4];
#pragma unroll
    for (int ks = 0; ks < 4; ++ks) kadr[ks] = 256 * r + 16 * ((8 * mp + 2 * ks + h) ^ fr_);
    const int i16 = lane & 15, q4 = i16 >> 2, p4 = i16 & 3, gg = (lane >> 4) & 1;
    int vlow[2], ebx[4];
#pragma unroll
    for (int jh = 0; jh < 2; ++jh) vlow[jh] = 256 * (8 * jh + 4 * h + q4) + 16 * ((2 * gg + (p4 >> 1)) ^ (2 * jh + h)) + 8 * (p4 & 1);
#pragma unroll
    for (int eb = 0; eb < 4; ++eb) ebx[eb] = 64 * (eb ^ q4);
    f32x16 o[4];
#pragma unroll
    for (int eb = 0; eb < 4; ++eb) o[eb] = (f32x16){};
    float mrun = -1e30f, lrun = 0.f;
#define DIFF_DMA(t, bi) do { const char* src_ = gb + (size_t)(t) * 64 * INW * 2; _Pragma("unroll") for (int i_ = 0; i_ < 2; ++i_) { \
        dma16(src_ + koff[i_], lds + (bi) * 32768 + (wid * 2 + i_) * 1024); dma16(src_ + voff[i_], lds + (bi) * 32768 + 16384 + (wid * 2 + i_) * 1024); } } while (0)
    DIFF_DMA(0, 0);
    for (int t = 0; t < NT; ++t) {
        WAITV0(); __syncthreads();
        if (t + 1 < NT) DIFF_DMA(t + 1, (t + 1) & 1);
        if (64 * t <= q0 + 31) {
            LAS const unsigned char* Kb = lds + (t & 1) * 32768; LAS const unsigned char* Vb = Kb + 16384;
            f32x16 st[2];
#pragma unroll
            for (int kb = 0; kb < 2; ++kb) { st[kb] = (f32x16){};
#pragma unroll
                for (int ks = 0; ks < 4; ++ks) { const bf16x8 kf = *(const LAS bf16x8*)(Kb + kb * 8192 + kadr[ks]); st[kb] = MFMA32(kf, qf[ks], st[kb]); } }
            const float base = (float)(64 * t + 4 * h - iq) * c2;
            const int lim = iq - 64 * t - 4 * h;
            const bool msk = (64 * t + 63 > q0);
            float mx = -1e30f;
#pragma unroll
            for (int kb = 0; kb < 2; ++kb)
#pragma unroll
                for (int i = 0; i < 16; ++i) { const int jrel = 32 * kb + (i & 3) + 8 * (i >> 2);
                    float s = st[kb][i] * c1 + (base + c2 * (float)jrel);
                    if (msk && jrel > lim) s = -INFINITY;
                    st[kb][i] = s; mx = fmaxf(mx, s); }
            mx = xhalf_max(mx);
            const float mnew = fmaxf(mrun, mx), alpha = __builtin_amdgcn_exp2f(mrun - mnew);
            mrun = mnew;
            float ls = 0.f;
#pragma unroll
            for (int kb = 0; kb < 2; ++kb)
#pragma unroll
                for (int i = 0; i < 16; ++i) { const float p = __builtin_amdgcn_exp2f(st[kb][i] - mnew); st[kb][i] = p; ls += p; }
            lrun = lrun * alpha + ls;
#pragma unroll
            for (int eb = 0; eb < 4; ++eb) o[eb] = o[eb] * alpha;
            bf16x8 pf[4];
#pragma unroll
            for (int s = 0; s < 4; ++s) pf[s] = pack8(st[s >> 1], 8 * (s & 1));
#pragma unroll
            for (int s = 0; s < 4; ++s)
#pragma unroll
                for (int eb = 0; eb < 4; ++eb) {
                    const s16x4 lo = vtr(Vb + vlow[0] + ebx[eb] + 4096 * s), hi = vtr(Vb + vlow[1] + ebx[eb] + 4096 * s);
                    const bf16x8 vf = __builtin_shufflevector(lo, hi, 0, 1, 2, 3, 4, 5, 6, 7);
                    o[eb] = MFMA32(vf, pf[s], o[eb]);
                }
        }
    }
#undef DIFF_DMA
    { const float lt = xhalf_sum(lrun), inv = 1.f / lt;
#pragma unroll
      for (int eb = 0; eb < 4; ++eb) o[eb] = o[eb] * inv; }
    __syncthreads();
    LAS float* X = (LAS float*)(lds + qg * 16384);
    if (mp == 1) {
#pragma unroll
        for (int eb = 0; eb < 4; ++eb)
#pragma unroll
            for (int i = 0; i < 16; ++i) X[(eb * 16 + i) * 64 + lane] = o[eb][i];
    }
    __syncthreads();
    if (mp == 0) {
        float ss = 0.f;
#pragma unroll
        for (int eb = 0; eb < 4; ++eb)
#pragma unroll
            for (int i = 0; i < 16; ++i) { const float d = o[eb][i] - lam * X[(eb * 16 + i) * 64 + lane]; o[eb][i] = d; ss += d * d; }
        ss = xhalf_sum(ss);
        const float rs = __builtin_amdgcn_rsqf(ss * (1.f / 128.f) + EPS) * 0.8f;
        bf16_t* op = rowb + (size_t)iq * INW + C_DQ + head * 128 + 4 * h;
#pragma unroll
        for (int eb = 0; eb < 4; ++eb)
#pragma unroll
            for (int g4 = 0; g4 < 4; ++g4) { const int e = 32 * eb + 8 * g4; const f32x4 w = *(const f32x4*)(subln + e + 4 * h);
                u32x2 v; v.x = cvt_pk_bf16(o[eb][4 * g4 + 0] * rs * w[0], o[eb][4 * g4 + 1] * rs * w[1]); v.y = cvt_pk_bf16(o[eb][4 * g4 + 2] * rs * w[2], o[eb][4 * g4 + 3] * rs * w[3]);
                *(u32x2*)(op + e) = v; }
    }
    __syncthreads();
}

DI void ret_unit(LAS unsigned char* lds, bf16_t* P, int b, int head, int qb, const int wid) {
    const int lane = olane(), r = lane & 31, h = lane >> 5;
    const int hh = wid >> 2, qg = wid & 3, q0 = 128 * qb + 32 * qg, iq = q0 + r;
    bf16_t* rowb = P + (size_t)b * SEQ * INW;
    bf16x8 qf[8];
    { const bf16_t* qp = rowb + (size_t)iq * INW + C_RQ + head * 256 + 128 * hh + 8 * h;
#pragma unroll
      for (int ks = 0; ks < 8; ++ks) qf[ks] = *(const bf16x8*)(qp + 16 * ks); }
    const int NT = 4 * (qb + 1);
    unsigned goff[6];
#pragma unroll
    for (int i = 0; i < 6; ++i) { const int L = wid * 6 + i;
        if (L < 16) { const int row = 2 * L + (lane >> 5), pos = lane & 31, ch = (pos & 16) + ((pos & 15) ^ fsw(row)); goff[i] = (unsigned)(row * INW + C_RK + head * 256 + ch * 8) * 2u; }
        else { const int row = L - 16, ch = (lane & 48) + ((lane & 15) ^ fsw(row)); goff[i] = (unsigned)(row * INW + C_RV + head * 512 + ch * 8) * 2u; } }
    const char* gb = (const char*)rowb;
    const float lg = __builtin_amdgcn_logf(1.f - __builtin_amdgcn_exp2f(-5.f - (float)head));
    const int fr_ = fsw(r);
    const int i16 = lane & 15, q4 = i16 >> 2, p4 = i16 & 3, gg = (lane >> 4) & 1;
    int vlow[2], ebx[4];
#pragma unroll
    for (int jh = 0; jh < 2; ++jh) vlow[jh] = 1024 * (8 * jh + 4 * h + q4) + 16 * ((2 * gg + (p4 >> 1)) ^ (2 * jh + h)) + 8 * (p4 & 1) + 512 * hh;
#pragma unroll
    for (int e3 = 0; e3 < 4; ++e3) ebx[e3] = 64 * (e3 ^ q4);
    LAS float* XS = (LAS float*)(lds + 98304 + wid * 4096) + lane;
    LAS const float* XP = (LAS const float*)(lds + 98304 + (wid ^ 4) * 4096) + lane;
    f32x16 o[8];
#pragma unroll
    for (int eb = 0; eb < 8; ++eb) o[eb] = (f32x16){};
#define RET_DMA(t, bi) do { const char* src_ = gb + (size_t)(t) * 32 * INW * 2; _Pragma("unroll") for (int i_ = 0; i_ < 6; ++i_) dma16(src_ + goff[i_], lds + (bi) * 49152 + (wid * 6 + i_) * 1024); } while (0)
    RET_DMA(0, 0);
    for (int t = 0; t < NT; ++t) {
        WAITV0(); __syncthreads();
        if (t + 1 < NT) RET_DMA(t + 1, (t + 1) & 1);
        const bool live = (32 * t <= q0 + 31);
        LAS const unsigned char* Kb = lds + (t & 1) * 49152; LAS const unsigned char* Vb = Kb + 16384;
        f32x16 st = (f32x16){};
        if (live) {
#pragma unroll
            for (int ks = 0; ks < 8; ++ks) { const bf16x8 kf = *(const LAS bf16x8*)(Kb + 512 * r + 256 * hh + 16 * ((2 * ks + h) ^ fr_)); st = MFMA32(kf, qf[ks], st); }
#pragma unroll
            for (int i = 0; i < 16; ++i) XS[i * 64] = st[i];
        }
        __syncthreads();
        if (live) {
#pragma unroll
            for (int i = 0; i < 16; ++i) st[i] += XP[i * 64];
            const float dist0 = (float)(iq - 32 * t - 4 * h);
            const bool msk = (32 * t + 31 > q0);
#pragma unroll
            for (int i = 0; i < 16; ++i) { const float d = dist0 - (float)((i & 3) + 8 * (i >> 2));
                float p = st[i] * __builtin_amdgcn_exp2f(lg * d);
                if (msk && d < 0.f) p = 0.f;
                st[i] = p; }
            bf16x8 pf[2];
            pf[0] = pack8(st, 0); pf[1] = pack8(st, 8);
#pragma unroll
            for (int s = 0; s < 2; ++s)
#pragma unroll
                for (int eb = 0; eb < 8; ++eb) {
                    const int co = 256 * (eb >> 2) + 16384 * s;
                    const s16x4 lo = vtr(Vb + vlow[0] + ebx[eb & 3] + co), hi = vtr(Vb + vlow[1] + ebx[eb & 3] + co);
                    const bf16x8 vf = __builtin_shufflevector(lo, hi, 0, 1, 2, 3, 4, 5, 6, 7);
                    o[eb] = MFMA32(vf, pf[s], o[eb]);
                }
        }
    }
#undef RET_DMA
    float s1 = 0.f, s2 = 0.f;
#pragma unroll
    for (int eb = 0; eb < 8; ++eb)
#pragma unroll
        for (int i = 0; i < 16; ++i) { const float v = o[eb][i]; s1 += v; s2 += v * v; }
    s1 = xhalf_sum(s1); s2 = xhalf_sum(s2);
    __syncthreads();
    LAS float* ST = (LAS float*)lds;
    if (h == 0) { ST[(wid * 32 + r) * 2] = s1; ST[(wid * 32 + r) * 2 + 1] = s2; }
    __syncthreads();
    { const float t1 = s1 + ST[((wid ^ 4) * 32 + r) * 2], t2 = s2 + ST[((wid ^ 4) * 32 + r) * 2 + 1];
      const float mean = t1 * (1.f / 512.f); const float var = fmaxf(t2 * (1.f / 512.f) - mean * mean, 0.f);
      const float rstd = __builtin_amdgcn_rsqf(var + EPS);
      bf16_t* op = rowb + (size_t)iq * INW + C_RG + head * 512 + 256 * hh + 4 * h;
#pragma unroll
      for (int eb = 0; eb < 8; ++eb)
#pragma unroll
          for (int g4 = 0; g4 < 4; ++g4) { bf16_t* pp = op + 32 * eb + 8 * g4; const u32x2 gq = *(const u32x2*)pp;
              u32x2 v; v.x = cvt_pk_bf16((o[eb][4 * g4 + 0] - mean) * rstd * bf_lo(gq.x), (o[eb][4 * g4 + 1] - mean) * rstd * bf_hi(gq.x));
              v.y = cvt_pk_bf16((o[eb][4 * g4 + 2] - mean) * rstd * bf_lo(gq.y), (o[eb][4 * g4 + 3] - mean) * rstd * bf_hi(gq.y));
              *(u32x2*)pp = v; } }
    __syncthreads();
}
}

DI void tr_item(const float* W, int K, int N, bf16_t* WT, int mode, LAS float* scr, int item, int lane) {
    const int nblk = N / 32, kb = item / nblk, nb = item % nblk, k0 = 64 * kb, n0 = 32 * nb;
    int rowbase = n0;
    if (mode) { const int which = n0 / FF, j = n0 - which * FF; rowbase = 256 * (j / 128) + 128 * which + (j % 128); }
#pragma unroll 8
    for (int i = 0; i < 32; ++i) { const int kk = 2 * i + (lane >> 5); scr[kk * 33 + (lane & 31)] = W[(size_t)(k0 + kk) * N + n0 + (lane & 31)]; }
    asm volatile("s_waitcnt lgkmcnt(0)" ::: "memory");
    const int c = lane & 7;
#pragma unroll
    for (int j = 0; j < 4; ++j) { const int n = (lane >> 3) + 8 * j; const LAS float* s = scr + (8 * c) * 33 + n;
        u32x4 o; o.x = cvt_pk_bf16(s[0 * 33], s[1 * 33]); o.y = cvt_pk_bf16(s[2 * 33], s[3 * 33]); o.z = cvt_pk_bf16(s[4 * 33], s[5 * 33]); o.w = cvt_pk_bf16(s[6 * 33], s[7 * 33]);
        *(u32x4*)(WT + (size_t)(rowbase + n) * K + k0 + 8 * c) = o; }
    asm volatile("s_waitcnt lgkmcnt(0)" ::: "memory");
}
DI void modulate_rows(const float* X, const float* g, const float* modsub, bf16_t* H, int ngw, const int wid) {
    const int lane = olane(), gw = blockIdx.x * 8 + wid;
    for (int m = gw; m < M; m += ngw) {
        const float* shift = modsub + (size_t)(m >> 11) * NMOD; const float* scale = shift + D;
        const f32x4* xr = (const f32x4*)(X + (size_t)m * D) + lane;
        f32x4 v[4]; float ss = 0.f;
#pragma unroll
        for (int j = 0; j < 4; ++j) { v[j] = xr[64 * j]; ss += (v[j].x * v[j].x + v[j].y * v[j].y) + (v[j].z * v[j].z + v[j].w * v[j].w); }
        const float rstd = __builtin_amdgcn_rsqf(wave_sum(ss) * (1.f / D) + EPS);
#pragma unroll
        for (int j = 0; j < 4; ++j) { const int k = 4 * (lane + 64 * j);
            const f32x4 gv = *(const f32x4*)(g + k), sc = *(const f32x4*)(scale + k), sh = *(const f32x4*)(shift + k);
            const f32x4 y = (v[j] * rstd * gv) * (sc + 1.f) + sh;
            u32x2 w; w.x = cvt_pk_bf16(y.x, y.y); w.y = cvt_pk_bf16(y.z, y.w);
            *(u32x2*)(H + (size_t)m * D + k) = w; }
    }
}

#define XB_TMO      128
#define XB_XCNT(j)  (256  + 64 * (j))
#define XB_XSUB(j)  (1280 + 64 * (j))
#define XB_XGEN(j)  (2304 + 64 * (j))
#define XB_TOP      3328
#define XB_TOPGEN   3392
#define XCD_BAR_WORDS 3456
#define XB_SPIN_CAP (1u << 18)
DI unsigned xb_ld(unsigned* p)              { return __hip_atomic_load(p, __ATOMIC_RELAXED, __HIP_MEMORY_SCOPE_AGENT); }
DI unsigned xb_add(unsigned* p, unsigned v) { return __hip_atomic_fetch_add(p, v, __ATOMIC_RELAXED, __HIP_MEMORY_SCOPE_AGENT); }
DI unsigned xb_xcc_id() { return (unsigned)__builtin_amdgcn_s_getreg((3 << 11) | 20) & 0xFu; }
#define XB_SPIN(cond, bar) do { unsigned _sp = 0; while (cond) { __builtin_amdgcn_s_sleep(1); \
    if ((++_sp & 255u) == 0u) { if (xb_ld(&(bar)[XB_TMO])) break; if (_sp > XB_SPIN_CAP) { atomicAdd(&(bar)[XB_TMO], 1u); break; } } } } while (0)
struct XcdBarrier { unsigned* bar; unsigned x; volatile LAS unsigned* st; };
DI XcdBarrier xcd_barrier_post(unsigned* bar, volatile LAS unsigned* st, bool lead) {
    XcdBarrier b; b.bar = bar; b.x = xb_xcc_id(); b.st = st;
    if (lead) (void)xb_add(&bar[XB_XCNT(b.x)], 1u);
    return b;
}
DI void xcd_barrier_complete(unsigned* bar, unsigned x, unsigned& nloc, unsigned& nx) {
    const unsigned G = gridDim.x * gridDim.y * gridDim.z;
    unsigned sum, cnt, mine, sp = 0u;
    for (;;) {
        sum = 0u; cnt = 0u; mine = 0u;
#pragma unroll
        for (unsigned j = 0; j < 16; ++j) { const unsigned c = xb_ld(&bar[XB_XCNT(j)]); sum += c; cnt += (c > 0u) ? 1u : 0u; mine = (j == x) ? c : mine; }
        if (sum == G) break;
        __builtin_amdgcn_s_sleep(1);
        if ((++sp & 255u) == 0u) { if (xb_ld(&bar[XB_TMO])) break; if (sp > XB_SPIN_CAP) { atomicAdd(&bar[XB_TMO], 1u); break; } }
    }
    nloc = mine > 0u ? mine : 1u; nx = cnt > 0u ? cnt : 1u;
}
DI void xcd_barrier(const XcdBarrier& b, bool lead) {
    asm volatile("s_waitcnt vmcnt(0)" ::: "memory");
    __syncthreads();
    if (lead) {
        unsigned* bar = b.bar;
        __builtin_amdgcn_s_waitcnt(0);
        unsigned nloc = b.st[0], nx = b.st[1];
        if (nloc == 0u) { xcd_barrier_complete(bar, b.x, nloc, nx); b.st[0] = nloc; b.st[1] = nx; }
        const unsigned old = xb_add(&bar[XB_XSUB(b.x)], 1u);
        const unsigned gen = old / nloc;
        if (old + 1u == (gen + 1u) * nloc) {
            __builtin_amdgcn_fence(__ATOMIC_RELEASE, "agent");
            asm volatile("s_waitcnt vmcnt(0)" ::: "memory");
            const unsigned og = xb_add(&bar[XB_TOP], 1u);
            const unsigned tg = og / nx;
            if (og + 1u == (tg + 1u) * nx) xb_add(&bar[XB_TOPGEN], 1u);
            else XB_SPIN(xb_ld(&bar[XB_TOPGEN]) == tg, bar);
            __builtin_amdgcn_fence(__ATOMIC_ACQUIRE, "agent");
            xb_add(&bar[XB_XGEN(b.x)], 1u);
            asm volatile("s_waitcnt vmcnt(0)" ::: "memory");
        } else {
            XB_SPIN(xb_ld(&bar[XB_XGEN(b.x)]) == gen, bar);
            __builtin_amdgcn_fence(__ATOMIC_ACQUIRE, "agent");
            asm volatile("s_waitcnt vmcnt(0)" ::: "memory");
        }
    }
    __syncthreads();
}

struct Args { const float* in[16]; float* out; unsigned char* ws; };

__global__ void __launch_bounds__(512, 2) mega(Args a) {
    extern __shared__ __attribute__((aligned(16))) unsigned char lds_raw[];
    LAS unsigned char* lds = (LAS unsigned char*)lds_raw;
    cg::grid_group grid = cg::this_grid();
    const int wid = __builtin_amdgcn_readfirstlane((int)threadIdx.x >> 6);
    const int G = gridDim.x, ngw = G * 8;
    unsigned char* ws = a.ws;
    const float* x_in = a.in[0];
    float* out = a.out;
    float* mod = (float*)(ws + WS_MOD);
    unsigned* ctl = (unsigned*)(ws + WS_CTL);
    bf16_t* W1I = (bf16_t*)(ws + WS_W1I); bf16_t* W1O = (bf16_t*)(ws + WS_W1O); bf16_t* WIN = (bf16_t*)(ws + WS_WIN);
    bf16_t* WRO = (bf16_t*)(ws + WS_WRO); bf16_t* WDO = (bf16_t*)(ws + WS_WDO); bf16_t* WO = (bf16_t*)(ws + WS_WO);
    bf16_t* H = (bf16_t*)(ws + WS_H); bf16_t* BIG = (bf16_t*)(ws + WS_BIG);
    LAS unsigned* sflag = (LAS unsigned*)(lds + 131072);
    if (wid == 0) { const int l0 = olane(); if (l0 < 8) sflag[l0] = 0u; }
    __syncthreads();
    const XcdBarrier xbar = xcd_barrier_post((unsigned*)(ws + WS_BAR), (volatile LAS unsigned*)(sflag + 2), wid == 0 && olane() == 0);
#define GSYNC() xcd_barrier(xbar, wid == 0 && olane() == 0)

    for (int item = blockIdx.x; item < NMOD / 64; item += G) {
        const int lane = olane(), tid = wid * 64 + lane;
        LAS float* cs = (LAS float*)lds; LAS float* red = (LAS float*)(lds + 32768);
        for (int i = tid; i < NB * D; i += 512) cs[i] = siluf_(a.in[1][i]);
        __syncthreads();
        const int col = item * 64 + lane, k0 = wid * 128;
        float acc[8];
#pragma unroll
        for (int b = 0; b < 8; ++b) acc[b] = 0.f;
        const float* wp = a.in[2] + (size_t)k0 * NMOD + col;
#pragma unroll 8
        for (int k = 0; k < 128; ++k) { const float w = wp[(size_t)k * NMOD];
#pragma unroll
            for (int b = 0; b < 8; ++b) acc[b] += cs[b * D + k0 + k] * w; }
#pragma unroll
        for (int b = 0; b < 8; ++b) red[(wid * 8 + b) * 64 + lane] = acc[b];
        __syncthreads();
        { float s = 0.f;
#pragma unroll
          for (int w = 0; w < 8; ++w) s += red[(w * 8 + wid) * 64 + lane];
          mod[(size_t)wid * NMOD + col] = s + a.in[3][col]; }
        __syncthreads();
    }
    {
        const int lane = olane(), gw = blockIdx.x * 8 + wid;
        LAS float* scr = (LAS float*)(lds + wid * 16384);
        constexpr int I_FI = (D / 64) * (2 * FF / 32), I_FO = (FF / 64) * (D / 32), I_IN = (D / 64) * (INW / 32), I_RO = (2048 / 64) * (D / 32), I_DO = (D / 64) * (D / 32);
        constexpr int NIT = I_FI + I_FO + I_IN + I_RO + 2 * I_DO;
        for (int it = gw; it < NIT; it += ngw) {
            int r = it;
            if (r < I_FI) { tr_item(a.in[5], D, 2 * FF, W1I, 1, scr, r, lane); continue; } r -= I_FI;
            if (r < I_FO) { tr_item(a.in[6], FF, D, W1O, 0, scr, r, lane); continue; } r -= I_FO;
            if (r < I_IN) { tr_item(a.in[7], D, INW, WIN, 0, scr, r, lane); continue; } r -= I_IN;
            if (r < I_RO) { tr_item(a.in[8], 2048, D, WRO, 0, scr, r, lane); continue; } r -= I_RO;
            if (r < I_DO) { tr_item(a.in[11], D, D, WDO, 0, scr, r, lane); continue; } r -= I_DO;
            tr_item(a.in[12], D, D, WO, 0, scr, r, lane);
        }
    }
    grid.sync();

#pragma unroll 1
    for (int stage = 0; stage < 2; ++stage) {
        modulate_rows(stage == 0 ? x_in : out, a.in[4] + (stage == 0 ? 0 : 2 * D), mod + (stage == 0 ? 0 : 2 * 3 * D), H, ngw, wid);
        GSYNC();
        { pg8::Gemm g{H, W1I, M, 2 * FF, D, D, D}; pg8::StaticOrder S; S.init(M, 2 * FF, G, (int)blockIdx.x);
          pg8::EpiSwiglu E{BIG, FF};
          pg8::gemm_phase<pg8::EpiSwiglu, pg8::StaticOrder>(lds, g, S, E, wid); }
        GSYNC();
        { pg8::Gemm g{BIG, W1O, M, D, FF, FF, FF}; pg8::StaticOrder S; S.init(M, D, G, (int)blockIdx.x);
          pg8::EpiResid E{stage == 0 ? x_in : out, out, mod + (stage == 0 ? 0 : 2 * 3 * D) + 2 * D, 0.5f, 0};
          pg8::gemm_phase<pg8::EpiResid, pg8::StaticOrder>(lds, g, S, E, wid); }
        GSYNC();
        if (stage == 1) break;

        modulate_rows(out, a.in[4] + D, mod + 3 * D, H, ngw, wid);
        {
            const int lane = olane(), gw = blockIdx.x * 8 + wid;
            LAS float* scr = (LAS float*)(lds + wid * 16384);
            constexpr int I_FI = (D / 64) * (2 * FF / 32), I_FO = (FF / 64) * (D / 32);
            for (int it = gw; it < I_FI + I_FO; it += ngw) {
                if (it < I_FI) tr_item(a.in[13], D, 2 * FF, W1I, 1, scr, it, lane);
                else tr_item(a.in[14], FF, D, W1O, 0, scr, it - I_FI, lane);
            }
        }
        GSYNC();
        { const int lane = olane(); const float* lp = a.in[9]; const float s01 = wave_sum(lp[lane] * lp[64 + lane]), s23 = wave_sum(lp[128 + lane] * lp[192 + lane]);
          if (wid == 0 && lane == 0) ((LAS float*)sflag)[1] = __expf(s01) - __expf(s23) + 0.2f; }
#pragma unroll 1
        for (int grp = 0; grp < NB / GB; ++grp) {
            { pg8::Gemm g{H + (size_t)grp * MG * D, WIN, MG, INW, D, D, D}; pg8::StaticOrder S; S.init(MG, INW, G, (int)blockIdx.x);
              pg8::EpiProj E{BIG};
              pg8::gemm_phase<pg8::EpiProj, pg8::StaticOrder>(lds, g, S, E, wid); }
            GSYNC();
            for (;;) {
                if (wid == 0 && olane() == 0) sflag[0] = atomicAdd(ctl + 64 * grp, 1u);
                __syncthreads();
                const int u = (int)sflag[0];
                __syncthreads();
                if (u >= 256 + 512) break;
                if (u < 256) { const int qb = 15 - (u >> 4), bh = u & 15; att::ret_unit(lds, BIG, bh >> 2, bh & 3, qb, wid); }
                else { const int j = u - 256, qb = 15 - (j >> 5), bh = j & 31; att::diff_unit(lds, BIG, bh >> 3, bh & 7, qb, ((LAS float*)sflag)[1], a.in[10], wid); }
            }
            GSYNC();
            { pg8::StaticOrder S; S.init(MG, D, G, (int)blockIdx.x);
              { pg8::Gemm g{BIG + C_RG, WRO, MG, D, 2048, INW, 2048}; pg8::EpiY E{BIG, C_GT, 0}; pg8::gemm_phase<pg8::EpiY, pg8::StaticOrder>(lds, g, S, E, wid); }
              { pg8::Gemm g{BIG + C_DQ, WDO, MG, D, D, INW, D}; pg8::EpiY E{BIG, C_GT + D, 1}; pg8::gemm_phase<pg8::EpiY, pg8::StaticOrder>(lds, g, S, E, wid); } }
            GSYNC();
            { pg8::Gemm g{BIG, WO, MG, D, D, INW, D}; pg8::StaticOrder S; S.init(MG, D, G, (int)blockIdx.x);
              float* o2 = out + (size_t)grp * MG * D;
              pg8::EpiResid E{o2, o2, mod + 3 * D + 2 * D, 1.0f, grp * GB};
              pg8::gemm_phase<pg8::EpiResid, pg8::StaticOrder>(lds, g, S, E, wid); }
            GSYNC();
        }
    }
    const int lane = olane(), gw = blockIdx.x * 8 + wid;
    for (int m = gw; m < M; m += ngw) {
        f32x4* xr = (f32x4*)(out + (size_t)m * D) + lane;
        f32x4 v[4]; float ss = 0.f;
#pragma unroll
        for (int j = 0; j < 4; ++j) { v[j] = xr[64 * j]; ss += (v[j].x * v[j].x + v[j].y * v[j].y) + (v[j].z * v[j].z + v[j].w * v[j].w); }
        const float rstd = __builtin_amdgcn_rsqf(wave_sum(ss) * (1.f / D) + EPS);
#pragma unroll
        for (int j = 0; j < 4; ++j) { const f32x4 gv = *(const f32x4*)(a.in[15] + 4 * (lane + 64 * j)); xr[64 * j] = v[j] * rstd * gv; }
    }
}

extern "C" void kernel_launch(void* const* d_in, const int* in_sizes, int n_in, void* d_out, int out_size, void* d_ws, size_t ws_size, hipStream_t stream) {
    static int grid = 0;
    if (grid == 0) {
        if (n_in != 16 || out_size != M * D || ws_size < WS_END) { fprintf(stderr, "kernel_launch: unexpected problem (n_in %d out %d ws %zu)\n", n_in, out_size, ws_size); grid = -1; return; }
        int dev = 0, cus = 0, per_cu = 0;
        hipGetDevice(&dev); hipDeviceGetAttribute(&cus, hipDeviceAttributeMultiprocessorCount, dev);
        hipFuncSetAttribute((const void*)mega, hipFuncAttributeMaxDynamicSharedMemorySize, LDS_BYTES);
        hipOccupancyMaxActiveBlocksPerMultiprocessor(&per_cu, (const void*)mega, 512, LDS_BYTES);
        if (per_cu < 1) { fprintf(stderr, "kernel_launch: occupancy query says %d blocks per CU\n", per_cu); per_cu = 1; }
        grid = cus * 1;
    }
    if (grid < 0) return;
    hipMemsetAsync((char*)d_ws + WS_CTL, 0, CTL_ZERO, stream);
    Args a{};
    for (int i = 0; i < 16; ++i) a.in[i] = (const float*)d_in[i];
    a.out = (float*)d_out; a.ws = (unsigned char*)d_ws;
    void* args[] = {&a};
    hipError_t e = hipLaunchCooperativeKernel((const void*)mega, dim3(grid), dim3(512), args, LDS_BYTES, stream);
    if (e != hipSuccess) fprintf(stderr, "cooperative launch failed: %s (grid %d)\n", hipGetErrorString(e), grid);
}
```

```cpp
#include <hip/hip_runtime.h>
#include <hip/hip_cooperative_groups.h>
#include <cstdio>
#include <cstdint>
namespace cg = cooperative_groups;

#define LAS __attribute__((address_space(3)))
#define DI __device__ __forceinline__
typedef unsigned short bf16_t;
typedef short bf16x8 __attribute__((ext_vector_type(8)));
typedef float f32x4 __attribute__((ext_vector_type(4)));
typedef float f32x16 __attribute__((ext_vector_type(16)));
typedef unsigned u32x4 __attribute__((ext_vector_type(4)));
typedef unsigned u32x2 __attribute__((ext_vector_type(2)));
typedef short s16x4 __attribute__((ext_vector_type(4)));

constexpr int D = 1024, SEQ = 2048, NB = 8, M = NB * SEQ, FF = 2816, INW = 11264, NMOD = 9216;
constexpr int GB = 4, MG = GB * SEQ;
constexpr int C_RQ = 0, C_RK = 1024, C_RV = 2048, C_RG = 4096, C_DQ = 6144, C_DK = 7168, C_DV = 8192, C_GT = 9216;
constexpr float EPS = 1e-6f;
constexpr size_t MiB = 1u << 20;
constexpr size_t WS_CTL = 0, WS_BAR = 16384, CTL_ZERO = 65536, WS_MOD = 65536, WS_W1I = 1 * MiB, WS_W1O = 12 * MiB, WS_WIN = 18 * MiB, WS_WRO = 40 * MiB, WS_WDO = 44 * MiB, WS_WO = 46 * MiB,
                 WS_H = 48 * MiB, WS_BIG = 80 * MiB, WS_END = 256 * MiB;
constexpr int LDS_BYTES = 131072 + 256;

DI unsigned cvt_pk_bf16(float lo, float hi) { unsigned r; asm volatile("v_cvt_pk_bf16_f32 %0, %1, %2" : "=v"(r) : "v"(lo), "v"(hi)); return r; }
DI float bf_lo(unsigned w) { return __uint_as_float(w << 16); }
DI float bf_hi(unsigned w) { return __uint_as_float(w & 0xffff0000u); }
DI float sigmoidf_(float x) { return __builtin_amdgcn_rcpf(1.f + __expf(-x)); }
DI float siluf_(float x) { return x * sigmoidf_(x); }
DI unsigned char* opq(unsigned char* p) { asm volatile("" : "+s"(p)); return p; }
DI int opqi(int v) { asm volatile("" : "+s"(v)); return v; }
DI int olane() { int l = __builtin_amdgcn_mbcnt_hi(~0u, __builtin_amdgcn_mbcnt_lo(~0u, 0u)); asm volatile("" : "+v"(l)); return l; }
DI float wave_sum(float v) {
    int l = __builtin_amdgcn_mbcnt_hi(~0u, __builtin_amdgcn_mbcnt_lo(~0u, 0u)); asm volatile("" : "+v"(l));
#pragma unroll
    for (int o = 1; o < 64; o <<= 1) v += __uint_as_float(__builtin_amdgcn_ds_bpermute((l ^ o) << 2, __float_as_uint(v)));
    return v;
}
DI float xhalf_sum(float v) { auto rr = __builtin_amdgcn_permlane32_swap(__float_as_uint(v), __float_as_uint(v), false, false); return __uint_as_float(rr[0]) + __uint_as_float(rr[1]); }
DI float xhalf_max(float v) { auto rr = __builtin_amdgcn_permlane32_swap(__float_as_uint(v), __float_as_uint(v), false, false); return fmaxf(__uint_as_float(rr[0]), __uint_as_float(rr[1])); }

namespace pg8 {
constexpr int BM = 256, BK = 64, HALF = 128, HTB = HALF * BK * 2, STAGE_BYTES = 8 * HTB, NXCD = 8, WGM = 8;
__host__ __device__ __forceinline__ int lds_byte(int r, int c) { const int st = (r >> 4) * 2 + (c >> 5), rr = r & 15, cc = c & 31, ob = rr * 64 + cc * 2; return st * 1024 + (ob ^ (((ob >> 9) & 1) << 5)); }
__host__ __device__ __forceinline__ void stage_rc(int b, int& R, int& C) { const int st = b / 1024, sb = b % 1024, swz = sb ^ (((sb >> 9) & 1) << 5); R = (st >> 1) * 16 + swz / 64; C = (st & 1) * 32 + (swz % 64) / 2; }
__host__ __device__ __forceinline__ int perm32(int rho) { const int n = rho >> 4, i = rho & 15; return 8 * (i >> 2) + 4 * n + (i & 3); }

struct Unit { int pm, pn; };
struct Gemm { const bf16_t* A; const bf16_t* Bt; int M, N, K, lda, ldb; };

struct StaticOrder {
    int nM, nN, nwg, G, c;
    __host__ __device__ void init(int M_, int N_, int G_, int c_) { nM = M_ / BM; nN = N_ / BM; nwg = nM * nN; G = G_; c = c_; }
    __host__ __device__ bool next(int i, Unit& u) const {
        const long L = (long)i * G + c; if (L >= nwg) return false;
        int wgid = (int)L; { const int q = nwg / NXCD, r = nwg % NXCD, xcd = wgid % NXCD, off = wgid / NXCD; wgid = (xcd < r ? xcd * (q + 1) : r * (q + 1) + (xcd - r) * q) + off; }
        const int nig = WGM * nN, gid = wgid / nig, fm = gid * WGM, gsz = (nM - fm) < WGM ? (nM - fm) : WGM;
        u.pm = fm + ((wgid % nig) % gsz); u.pn = (wgid % nig) / gsz; return true;
    }
};


struct EpiSwiglu {
    static constexpr bool PERM = true;
    bf16_t* U; int ldc;
    DI void operator()(const f32x4 (&acc)[2][2][4][2], const Unit& u, int wr, int wc, int fr, int fq) const {
        const int row0 = u.pm * BM + wr * 64 + fr, col0 = u.pn * 128 + wc * 32 + 8 * fq;
#pragma unroll
        for (int ai = 0; ai < 2; ++ai)
#pragma unroll
            for (int m = 0; m < 4; ++m) {
                bf16_t* rowp = U + (size_t)(row0 + ai * HALF + m * 16) * ldc + col0;
                const f32x4 a0 = acc[ai][0][m][0], a1 = acc[ai][0][m][1], b0 = acc[ai][1][m][0], b1 = acc[ai][1][m][1];
                float v[8];
#pragma unroll
                for (int i = 0; i < 4; ++i) { v[i] = siluf_(a0[i]) * b0[i]; v[4 + i] = siluf_(a1[i]) * b1[i]; }
                u32x4 w; w.x = cvt_pk_bf16(v[0], v[1]); w.y = cvt_pk_bf16(v[2], v[3]); w.z = cvt_pk_bf16(v[4], v[5]); w.w = cvt_pk_bf16(v[6], v[7]);
                *(u32x4*)rowp = w;
            }
    }
};
struct EpiResid {
    static constexpr bool PERM = false;
    const float* base; float* out; const float* gate; float coef; int b0;
    DI void operator()(const f32x4 (&acc)[2][2][4][2], const Unit& u, int wr, int wc, int fr, int fq) const {
        const int row0 = u.pm * BM + wr * 64 + fr, col0 = u.pn * BM + wc * 32 + 4 * fq;
        const float* gp = gate + (size_t)(b0 + (u.pm >> 3)) * NMOD + col0;
        f32x4 gv[2][2];
#pragma unroll
        for (int bj = 0; bj < 2; ++bj)
#pragma unroll
            for (int n = 0; n < 2; ++n) gv[bj][n] = *(const f32x4*)(gp + bj * HALF + n * 16) * coef;
#pragma unroll
        for (int ai = 0; ai < 2; ++ai)
#pragma unroll
            for (int m = 0; m < 4; ++m) {
                const size_t off = (size_t)(row0 + ai * HALF + m * 16) * D + col0;
#pragma unroll
                for (int bj = 0; bj < 2; ++bj)
#pragma unroll
                    for (int n = 0; n < 2; ++n) { const f32x4 x = *(const f32x4*)(base + off + bj * HALF + n * 16); *(f32x4*)(out + off + bj * HALF + n * 16) = x + gv[bj][n] * acc[ai][bj][m][n]; }
            }
    }
};
struct EpiProj {
    static constexpr bool PERM = true;
    bf16_t* P;
    DI void operator()(const f32x4 (&acc)[2][2][4][2], const Unit& u, int wr, int wc, int fr, int fq) const {
        const int row0 = u.pm * BM + wr * 64 + fr, col0 = u.pn * BM + wc * 32 + 8 * fq;
        const int t = u.pn >> 2; const int act = (t == 1) ? 1 : ((t == 4 || t == 5) ? 2 : ((t >= 9) ? 3 : ((t == 6) ? 4 : 0)));
        const float lgh = __builtin_amdgcn_logf(1.f - __builtin_amdgcn_exp2f(-5.f - (float)(u.pn & 3)));
#pragma unroll
        for (int ai = 0; ai < 2; ++ai)
#pragma unroll
            for (int m = 0; m < 4; ++m) {
                bf16_t* rowp = P + (size_t)(row0 + ai * HALF + m * 16) * INW + col0;
#pragma unroll
                for (int bj = 0; bj < 2; ++bj) {
                    f32x4 v0 = acc[ai][bj][m][0], v1 = acc[ai][bj][m][1];
                    if (act == 1) { const float f = 0.0625f * __builtin_amdgcn_exp2f(lgh * (float)(31 - ((row0 + m * 16) & 31))); v0 = v0 * f; v1 = v1 * f; }
                    else if (act == 4) { v0 = v0 * 0.18033688011112042f; v1 = v1 * 0.18033688011112042f; }
                    else if (act == 2) {
#pragma unroll
                        for (int i = 0; i < 4; ++i) { v0[i] = siluf_(v0[i]); v1[i] = siluf_(v1[i]); } }
                    else if (act == 3) {
#pragma unroll
                        for (int i = 0; i < 4; ++i) { v0[i] = sigmoidf_(v0[i]); v1[i] = sigmoidf_(v1[i]); } }
                    u32x4 w; w.x = cvt_pk_bf16(v0[0], v0[1]); w.y = cvt_pk_bf16(v0[2], v0[3]); w.z = cvt_pk_bf16(v1[0], v1[1]); w.w = cvt_pk_bf16(v1[2], v1[3]);
                    *(u32x4*)(rowp + bj * HALF) = w;
                }
            }
    }
};
struct EpiY {
    static constexpr bool PERM = true;
    bf16_t* P; int gcol; int add;
    DI void operator()(const f32x4 (&acc)[2][2][4][2], const Unit& u, int wr, int wc, int fr, int fq) const {
        const int row0 = u.pm * BM + wr * 64 + fr, col0 = u.pn * BM + wc * 32 + 8 * fq;
#pragma unroll
        for (int ai = 0; ai < 2; ++ai)
#pragma unroll
            for (int m = 0; m < 4; ++m) {
                bf16_t* rowp = P + (size_t)(row0 + ai * HALF + m * 16) * INW + col0;
#pragma unroll
                for (int bj = 0; bj < 2; ++bj) {
                    const f32x4 v0 = acc[ai][bj][m][0], v1 = acc[ai][bj][m][1];
                    const u32x4 g = *(const u32x4*)(rowp + gcol + bj * HALF);
                    float o[8];
                    o[0] = bf_lo(g.x) * v0[0]; o[1] = bf_hi(g.x) * v0[1]; o[2] = bf_lo(g.y) * v0[2]; o[3] = bf_hi(g.y) * v0[3];
                    o[4] = bf_lo(g.z) * v1[0]; o[5] = bf_hi(g.z) * v1[1]; o[6] = bf_lo(g.w) * v1[2]; o[7] = bf_hi(g.w) * v1[3];
                    if (add) { const u32x4 y = *(const u32x4*)(rowp + bj * HALF);
                        o[0] += bf_lo(y.x); o[1] += bf_hi(y.x); o[2] += bf_lo(y.y); o[3] += bf_hi(y.y); o[4] += bf_lo(y.z); o[5] += bf_hi(y.z); o[6] += bf_lo(y.w); o[7] += bf_hi(y.w); }
                    u32x4 w; w.x = cvt_pk_bf16(o[0], o[1]); w.y = cvt_pk_bf16(o[2], o[3]); w.z = cvt_pk_bf16(o[4], o[5]); w.w = cvt_pk_bf16(o[6], o[7]);
                    *(u32x4*)(rowp + bj * HALF) = w;
                }
            }
    }
};

template <class Epi, class Sched>
DI void gemm_phase(LAS unsigned char* lds, const Gemm g, const Sched& S, const Epi& E, const int wid) {
    const int lane = olane(), tid = wid * 64 + lane, wr = wid >> 2, wc = wid & 3, fr = lane & 15, fq = lane >> 4;
    const int K = g.K, nt = K / BK;
    unsigned voffA[2], voffB[2];
#pragma unroll
    for (int i = 0; i < 2; ++i) { int R, C; stage_rc(tid * 16 + i * 8192, R, C); const int Rb = Epi::PERM ? ((R & ~31) + perm32(R & 31)) : R;
        voffA[i] = (unsigned)(R * g.lda + C) * 2u; voffB[i] = (unsigned)(Rb * g.ldb + C) * 2u; }
    const size_t kstep = (size_t)(BK * 2);
    const size_t hsA = (size_t)HALF * g.lda * 2, hsB = (size_t)HALF * g.ldb * 2;
    const size_t tsA = 2 * hsA, tsB = 2 * hsB;
    const unsigned ldsw = (unsigned)wid * 1024u;
    const int aoff = lds_byte(wr * 64 + fr, fq * 8), boff = lds_byte(wc * 32 + fr, fq * 8);
#define PG8_SA(b, h) (((b) * 2 + (h)) * HTB)
#define PG8_SB(b, h) ((4 + (b) * 2 + (h)) * HTB)
#define PG8_STAGE(bufoff, gbase, voff) do { _Pragma("unroll") for (int _i = 0; _i < 2; ++_i) \
        __builtin_amdgcn_global_load_lds((const unsigned*)((const char*)(gbase) + (voff)[_i]), (LAS unsigned*)(lds + (bufoff) + ldsw + _i * 8192), 16, 0, 0); } while (0)
#define PG8_LDA(dst, b, h) do { _Pragma("unroll") for (int m = 0; m < 4; ++m) _Pragma("unroll") for (int k = 0; k < 2; ++k) dst[m][k] = *(const LAS bf16x8*)(lds + PG8_SA(b, h) + aoff + m * 2048 + k * 1024); } while (0)
#define PG8_LDB(dst, b, h) do { _Pragma("unroll") for (int n = 0; n < 2; ++n) _Pragma("unroll") for (int k = 0; k < 2; ++k) dst[n][k] = *(const LAS bf16x8*)(lds + PG8_SB(b, h) + boff + n * 2048 + k * 1024); } while (0)
#define PG8_MMA(ai, bj, At, Bt) do { __builtin_amdgcn_s_setprio(1); _Pragma("unroll") for (int m = 0; m < 4; ++m) _Pragma("unroll") for (int n = 0; n < 2; ++n) _Pragma("unroll") for (int k = 0; k < 2; ++k) \
        acc[ai][bj][m][n] = __builtin_amdgcn_mfma_f32_16x16x32_bf16(Bt[n][k], At[m][k], acc[ai][bj][m][n], 0, 0, 0); __builtin_amdgcn_s_setprio(0); } while (0)
#define PG8_WAIT_V(n) asm volatile("s_waitcnt vmcnt(" #n ")" ::: "memory")
#define PG8_WAIT_L(n) asm volatile("s_waitcnt lgkmcnt(" #n ")" ::: "memory")
#define PG8_BAR __builtin_amdgcn_s_barrier()
#define PG8_SCHED __builtin_amdgcn_sched_barrier(0)
    Unit cur, nxt; int ui = 0;
    if (!S.next(0, cur)) return;
    f32x4 acc[2][2][4][2];
#pragma unroll
    for (int a = 0; a < 2; ++a)
#pragma unroll
        for (int b = 0; b < 2; ++b)
#pragma unroll
            for (int m = 0; m < 4; ++m)
#pragma unroll
                for (int n = 0; n < 2; ++n) acc[a][b][m][n] = (f32x4){0.f, 0.f, 0.f, 0.f};
    bf16x8 At[4][2], B0[2][2], B1[2][2];
    const char* cA = (const char*)g.A + (size_t)cur.pm * tsA; const char* cB = (const char*)g.Bt + (size_t)cur.pn * tsB;
    PG8_STAGE(PG8_SB(0, 0), cB, voffB); PG8_STAGE(PG8_SB(0, 1), cB + hsB, voffB); PG8_STAGE(PG8_SA(0, 0), cA, voffA); PG8_STAGE(PG8_SA(0, 1), cA + hsA, voffA);
    if (wr == 1) PG8_BAR;
    PG8_WAIT_V(2); PG8_BAR;
    PG8_STAGE(PG8_SB(1, 0), cB + kstep, voffB); PG8_STAGE(PG8_SA(1, 0), cA + kstep, voffA); PG8_STAGE(PG8_SB(1, 1), cB + hsB + kstep, voffB);
    PG8_WAIT_V(6); PG8_BAR;
    for (;;) {
        const bool has_next = S.next(ui + 1, nxt);
        const char* nA = has_next ? (const char*)g.A + (size_t)nxt.pm * tsA : cA; const char* nB = has_next ? (const char*)g.Bt + (size_t)nxt.pn * tsB : cB;
        for (int t = 0; t < nt; t += 2) {
            const bool last = (t == nt - 2);
            const char* a1 = cA + (size_t)(t + 1) * kstep;
            const char* a2 = last ? nA : cA + (size_t)(t + 2) * kstep; const char* b2 = last ? nB : cB + (size_t)(t + 2) * kstep;
            const char* a3 = a2 + kstep; const char* b3 = b2 + kstep;
            PG8_LDB(B0, 0, 0); PG8_LDB(B1, 0, 1); PG8_SCHED; PG8_LDA(At, 0, 0); PG8_STAGE(PG8_SA(1, 1), a1 + hsA, voffA);
            PG8_WAIT_V(8); PG8_WAIT_L(0); PG8_BAR; PG8_MMA(0, 0, At, B0); PG8_MMA(0, 1, At, B1); PG8_BAR; PG8_SCHED;
            PG8_LDA(At, 0, 1); PG8_STAGE(PG8_SB(0, 0), b2, voffB); PG8_STAGE(PG8_SB(0, 1), b2 + hsB, voffB); PG8_STAGE(PG8_SA(0, 0), a2, voffA);
            PG8_WAIT_V(8); PG8_WAIT_L(0); PG8_BAR; PG8_MMA(1, 0, At, B0); PG8_MMA(1, 1, At, B1); PG8_BAR; PG8_SCHED;
            PG8_LDB(B0, 1, 0); PG8_LDB(B1, 1, 1); PG8_SCHED; PG8_LDA(At, 1, 0); PG8_STAGE(PG8_SA(0, 1), a2 + hsA, voffA);
            PG8_WAIT_V(8); PG8_WAIT_L(0); PG8_BAR; PG8_MMA(0, 0, At, B0); PG8_MMA(0, 1, At, B1); PG8_BAR; PG8_SCHED;
            PG8_LDA(At, 1, 1); PG8_STAGE(PG8_SB(1, 0), b3, voffB); PG8_STAGE(PG8_SB(1, 1), b3 + hsB, voffB); PG8_STAGE(PG8_SA(1, 0), a3, voffA);
            PG8_WAIT_V(8); PG8_WAIT_L(0); PG8_BAR; PG8_MMA(1, 0, At, B0); PG8_MMA(1, 1, At, B1); PG8_BAR; PG8_SCHED;
        }
        if (wr == 0) PG8_BAR;
        E(acc, cur, wr, wc, fr, fq);
        if (!has_next) break;
#pragma unroll
        for (int a = 0; a < 2; ++a)
#pragma unroll
            for (int b = 0; b < 2; ++b)
#pragma unroll
                for (int m = 0; m < 4; ++m)
#pragma unroll
                    for (int n = 0; n < 2; ++n) acc[a][b][m][n] = (f32x4){0.f, 0.f, 0.f, 0.f};
        cur = nxt; cA = nA; cB = nB; ++ui;
        if (wr == 1) PG8_BAR;
    }
    PG8_WAIT_V(0);
    PG8_BAR;
#undef PG8_SA
#undef PG8_SB
#undef PG8_STAGE
#undef PG8_LDA
#undef PG8_LDB
#undef PG8_MMA
#undef PG8_WAIT_V
#undef PG8_WAIT_L
#undef PG8_BAR
#undef PG8_SCHED
}
}

namespace att {
typedef short v4i16_t __attribute__((ext_vector_type(4)));
DI int fsw(int row) { return ((row & 3) << 2) | ((row >> 2) & 3); }
DI s16x4 vtr(LAS const unsigned char* p) { return __builtin_bit_cast(s16x4, __builtin_amdgcn_ds_read_tr16_b64_v4i16((LAS v4i16_t*)p)); }
DI void dma16(const void* g, LAS unsigned char* l) { __builtin_amdgcn_global_load_lds((const unsigned*)g, (LAS unsigned*)l, 16, 0, 0); }
#define MFMA32(a, b, c) __builtin_amdgcn_mfma_f32_32x32x16_bf16((a), (b), (c), 0, 0, 0)
DI bf16x8 pack8(const f32x16& x, int s8) {
    u32x4 p; p.x = cvt_pk_bf16(x[s8 + 0], x[s8 + 1]); p.y = cvt_pk_bf16(x[s8 + 2], x[s8 + 3]); p.z = cvt_pk_bf16(x[s8 + 4], x[s8 + 5]); p.w = cvt_pk_bf16(x[s8 + 6], x[s8 + 7]);
    return __builtin_bit_cast(bf16x8, p);
}
#define WAITV0() asm volatile("s_waitcnt vmcnt(0)" ::: "memory")

DI void diff_unit(LAS unsigned char* lds, bf16_t* P, int b, int head, int qb, float lam, const float* subln, const int wid) {
    const int lane = olane(), r = lane & 31, h = lane >> 5;
    const int mp = wid >> 2, qg = wid & 3, q0 = 128 * qb + 32 * qg, iq = q0 + r;
    bf16_t* rowb = P + (size_t)b * SEQ * INW;
    bf16x8 qf[4];
    { const bf16_t* qp = rowb + (size_t)iq * INW + C_DQ + head * 128 + mp * 64 + 8 * h;
#pragma unroll
      for (int ks = 0; ks < 4; ++ks) qf[ks] = *(const bf16x8*)(qp + 16 * ks); }
    const int NT = 2 * (qb + 1);
    unsigned koff[2], voff[2];
#pragma unroll
    for (int i = 0; i < 2; ++i) { const int L = wid * 2 + i, row = 4 * L + (lane >> 4), p = lane & 15, ch = p ^ fsw(row);
        koff[i] = (unsigned)(row * INW + C_DK + head * 128 + ch * 8) * 2u; voff[i] = (unsigned)(row * INW + C_DV + head * 128 + ch * 8) * 2u; }
    const char* gb = (const char*)rowb;
    const float slope = __builtin_amdgcn_exp2f(-(float)(head + 1));
    const float c2 = slope * 1.4426950408889634f, c2x5 = 5.f * c2;
    const int fr_ = fsw(r);
    int kadr[4];
#pragma unroll
    for (int ks = 0; ks < 4; ++ks) kadr[ks] = 256 * r + 16 * ((8 * mp + 2 * ks + h) ^ fr_);
    const int i16 = lane & 15, q4 = i16 >> 2, p4 = i16 & 3, gg = (lane >> 4) & 1;
    int vlow[2], ebx[4];
#pragma unroll
    for (int jh = 0; jh < 2; ++jh) vlow[jh] = 256 * (8 * jh + 4 * h + q4) + 16 * ((2 * gg + (p4 >> 1)) ^ (2 * jh + h)) + 8 * (p4 & 1);
#pragma unroll
    for (int eb = 0; eb < 4; ++eb) ebx[eb] = 64 * (eb ^ q4);
    int vadr[2][4];
#pragma unroll
    for (int jh = 0; jh < 2; ++jh)
#pragma unroll
        for (int eb = 0; eb < 4; ++eb) vadr[jh][eb] = vlow[jh] + ebx[eb];
    f32x16 o[4];
#pragma unroll
    for (int eb = 0; eb < 4; ++eb) o[eb] = (f32x16){};
    float mrun = 0.f, lrun = 0.f; bool first = true;
#define DIFF_DMA(t, bi) do { const char* src_ = gb + (size_t)(t) * 64 * INW * 2; _Pragma("unroll") for (int i_ = 0; i_ < 2; ++i_) { \
        dma16(src_ + koff[i_], lds + (bi) * 32768 + (wid * 2 + i_) * 1024); dma16(src_ + voff[i_], lds + (bi) * 32768 + 16384 + (wid * 2 + i_) * 1024); } } while (0)
    DIFF_DMA(NT - 1, 0);
    for (int it = 0; it < NT; ++it) {
        const int t = NT - 1 - it;
        WAITV0(); __syncthreads();
        if (it + 1 < NT) DIFF_DMA(t - 1, (it + 1) & 1);
        if (64 * t <= q0 + 31) {
            LAS const unsigned char* Kb = lds + (it & 1) * 32768; LAS const unsigned char* Vb = Kb + 16384;
            const float base = (float)(64 * t + 4 * h - iq) * c2 - mrun;
            f32x16 st[2];
            { float bv = base;
#pragma unroll
              for (int kb = 0; kb < 2; ++kb)
#pragma unroll
                  for (int i = 0; i < 16; ++i) { st[kb][i] = bv; bv += ((i & 3) == 3) ? c2x5 : c2; } }
#pragma unroll
            for (int kb = 0; kb < 2; ++kb) {
#pragma unroll
                for (int ks = 0; ks < 4; ++ks) { const bf16x8 kf = *(const LAS bf16x8*)(Kb + kb * 8192 + kadr[ks]); st[kb] = MFMA32(kf, qf[ks], st[kb]); } }
            __builtin_amdgcn_sched_barrier(0);
            if (64 * t + 63 > q0) {
                const int lim = iq - 64 * t - 4 * h;
#pragma unroll
                for (int kb = 0; kb < 2; ++kb)
#pragma unroll
                    for (int i = 0; i < 16; ++i) if (32 * kb + (i & 3) + 8 * (i >> 2) > lim) st[kb][i] = -INFINITY;
            }
            float mx = fmaxf(st[0][0], st[1][0]);
#pragma unroll
            for (int i = 1; i < 16; ++i) mx = fmaxf(mx, fmaxf(st[0][i], st[1][i]));
            mx = xhalf_max(mx);
            if (first) {
                first = false; mrun = mx;
#pragma unroll
                for (int kb = 0; kb < 2; ++kb)
#pragma unroll
                    for (int i = 0; i < 16; ++i) st[kb][i] -= mx;
            } else if (__any(mx > 5.f)) {
                const float dl = fmaxf(mx, 0.f), alpha = __builtin_amdgcn_exp2f(-dl);
                mrun += dl; lrun *= alpha;
#pragma unroll
                for (int kb = 0; kb < 2; ++kb)
#pragma unroll
                    for (int i = 0; i < 16; ++i) st[kb][i] -= dl;
#pragma unroll
                for (int eb = 0; eb < 4; ++eb) o[eb] = o[eb] * alpha;
            }
            float ls = 0.f;
#pragma unroll
            for (int kb = 0; kb < 2; ++kb)
#pragma unroll
                for (int i = 0; i < 16; ++i) { const float p = __builtin_amdgcn_exp2f(st[kb][i]); st[kb][i] = p; ls += p; }
            lrun += ls;
            bf16x8 pf[4];
#pragma unroll
            for (int s = 0; s < 4; ++s) pf[s] = pack8(st[s >> 1], 8 * (s & 1));
            __builtin_amdgcn_sched_barrier(0);
#pragma unroll
            for (int s = 0; s < 4; ++s) {
#pragma unroll
                for (int eb = 0; eb < 4; ++eb) {
                    const s16x4 lo = vtr(Vb + vadr[0][eb] + 4096 * s), hi = vtr(Vb + vadr[1][eb] + 4096 * s);
                    const bf16x8 vf = __builtin_shufflevector(lo, hi, 0, 1, 2, 3, 4, 5, 6, 7);
                    o[eb] = MFMA32(vf, pf[s], o[eb]);
                }
                __builtin_amdgcn_sched_barrier(0);
            }
        }
    }
#undef DIFF_DMA
    { const float lt = xhalf_sum(lrun), inv = 1.f / lt;
#pragma unroll
      for (int eb = 0; eb < 4; ++eb) o[eb] = o[eb] * inv; }
    __syncthreads();
    LAS float* X = (LAS float*)(lds + qg * 16384);
    if (mp == 1) {
#pragma unroll
        for (int eb = 0; eb < 4; ++eb)
#pragma unroll
            for (int i = 0; i < 16; ++i) X[(eb * 16 + i) * 64 + lane] = o[eb][i];
    }
    __syncthreads();
    if (mp == 0) {
        float ss = 0.f;
#pragma unroll
        for (int eb = 0; eb < 4; ++eb)
#pragma unroll
            for (int i = 0; i < 16; ++i) { const float d = o[eb][i] - lam * X[(eb * 16 + i) * 64 + lane]; o[eb][i] = d; ss += d * d; }
        ss = xhalf_sum(ss);
        const float rs = __builtin_amdgcn_rsqf(ss * (1.f / 128.f) + EPS) * 0.8f;
        bf16_t* op = rowb + (size_t)iq * INW + C_DQ + head * 128 + 4 * h;
#pragma unroll
        for (int eb = 0; eb < 4; ++eb)
#pragma unroll
            for (int g4 = 0; g4 < 4; ++g4) { const int e = 32 * eb + 8 * g4; const f32x4 w = *(const f32x4*)(subln + e + 4 * h);
                u32x2 v; v.x = cvt_pk_bf16(o[eb][4 * g4 + 0] * rs * w[0], o[eb][4 * g4 + 1] * rs * w[1]); v.y = cvt_pk_bf16(o[eb][4 * g4 + 2] * rs * w[2], o[eb][4 * g4 + 3] * rs * w[3]);
                *(u32x2*)(op + e) = v; }
    }
    __syncthreads();
}

DI void ret_unit(LAS unsigned char* lds, bf16_t* P, int b, int head, int qb, const int wid) {
    const int lane = olane(), r = lane & 31, h = lane >> 5;
    const int hh = wid >> 2, qg = wid & 3, q0 = 128 * qb + 32 * qg, iq = q0 + r;
    bf16_t* rowb = P + (size_t)b * SEQ * INW;
    bf16x8 qf[8];
    { const bf16_t* qp = rowb + (size_t)iq * INW + C_RQ + head * 256 + 128 * hh + 8 * h;
#pragma unroll
      for (int ks = 0; ks < 8; ++ks) qf[ks] = *(const bf16x8*)(qp + 16 * ks); }
    const int NT = 4 * (qb + 1);
    unsigned goff[6];
#pragma unroll
    for (int i = 0; i < 6; ++i) { const int L = wid * 6 + i;
        if (L < 16) { const int row = 2 * L + (lane >> 5), pos = lane & 31, ch = (pos & 16) + ((pos & 15) ^ fsw(row)); goff[i] = (unsigned)(row * INW + C_RK + head * 256 + ch * 8) * 2u; }
        else { const int row = L - 16, ch = (lane & 48) + ((lane & 15) ^ fsw(row)); goff[i] = (unsigned)(row * INW + C_RV + head * 512 + ch * 8) * 2u; } }
    const char* gb = (const char*)rowb;
    const float lg = __builtin_amdgcn_logf(1.f - __builtin_amdgcn_exp2f(-5.f - (float)head));
    const int fr_ = fsw(r);
    const int i16 = lane & 15, q4 = i16 >> 2, p4 = i16 & 3, gg = (lane >> 4) & 1;
    int vlow[2], ebx[4];
#pragma unroll
    for (int jh = 0; jh < 2; ++jh) vlow[jh] = 1024 * (8 * jh + 4 * h + q4) + 16 * ((2 * gg + (p4 >> 1)) ^ (2 * jh + h)) + 8 * (p4 & 1) + 512 * hh;
#pragma unroll
    for (int e3 = 0; e3 < 4; ++e3) ebx[e3] = 64 * (e3 ^ q4);
    LAS float* XS = (LAS float*)(lds + 98304 + wid * 4096) + lane;
    LAS const float* XP = (LAS const float*)(lds + 98304 + (wid ^ 4) * 4096) + lane;
    f32x16 o[8];
#pragma unroll
    for (int eb = 0; eb < 8; ++eb) o[eb] = (f32x16){};
#define RET_DMA(t, bi) do { const char* src_ = gb + (size_t)(t) * 32 * INW * 2; _Pragma("unroll") for (int i_ = 0; i_ < 6; ++i_) dma16(src_ + goff[i_], lds + (bi) * 49152 + (wid * 6 + i_) * 1024); } while (0)
    RET_DMA(0, 0);
    for (int t = 0; t < NT; ++t) {
        WAITV0(); __syncthreads();
        if (t + 1 < NT) RET_DMA(t + 1, (t + 1) & 1);
        const bool live = (32 * t <= q0 + 31);
        LAS const unsigned char* Kb = lds + (t & 1) * 49152; LAS const unsigned char* Vb = Kb + 16384;
        f32x16 st = (f32x16){};
        if (live) {
#pragma unroll
            for (int ks = 0; ks < 8; ++ks) { const bf16x8 kf = *(const LAS bf16x8*)(Kb + 512 * r + 256 * hh + 16 * ((2 * ks + h) ^ fr_)); st = MFMA32(kf, qf[ks], st); }
#pragma unroll
            for (int i = 0; i < 16; ++i) XS[i * 64] = st[i];
        }
        __syncthreads();
        if (live) {
#pragma unroll
            for (int i = 0; i < 16; ++i) st[i] += XP[i * 64];
            const float rowf = __builtin_amdgcn_exp2f(lg * (float)(iq - 32 * t - 31));
#pragma unroll
            for (int i = 0; i < 16; ++i) st[i] *= rowf;
            if (32 * t + 31 > q0) {
                const int lim = iq - 32 * t - 4 * h;
#pragma unroll
                for (int i = 0; i < 16; ++i) if ((i & 3) + 8 * (i >> 2) > lim) st[i] = 0.f;
            }
            bf16x8 pf[2];
            pf[0] = pack8(st, 0); pf[1] = pack8(st, 8);
#pragma unroll
            for (int s = 0; s < 2; ++s)
#pragma unroll
                for (int eb = 0; eb < 8; ++eb) {
                    const int co = 256 * (eb >> 2) + 16384 * s;
                    const s16x4 lo = vtr(Vb + vlow[0] + ebx[eb & 3] + co), hi = vtr(Vb + vlow[1] + ebx[eb & 3] + co);
                    const bf16x8 vf = __builtin_shufflevector(lo, hi, 0, 1, 2, 3, 4, 5, 6, 7);
                    o[eb] = MFMA32(vf, pf[s], o[eb]);
                }
        }
    }
#undef RET_DMA
    float s1 = 0.f, s2 = 0.f;
#pragma unroll
    for (int eb = 0; eb < 8; ++eb)
#pragma unroll
        for (int i = 0; i < 16; ++i) { const float v = o[eb][i]; s1 += v; s2 += v * v; }
    s1 = xhalf_sum(s1); s2 = xhalf_sum(s2);
    __syncthreads();
    LAS float* ST = (LAS float*)lds;
    if (h == 0) { ST[(wid * 32 + r) * 2] = s1; ST[(wid * 32 + r) * 2 + 1] = s2; }
    __syncthreads();
    { const float t1 = s1 + ST[((wid ^ 4) * 32 + r) * 2], t2 = s2 + ST[((wid ^ 4) * 32 + r) * 2 + 1];
      const float mean = t1 * (1.f / 512.f); const float var = fmaxf(t2 * (1.f / 512.f) - mean * mean, 0.f);
      const float rstd = __builtin_amdgcn_rsqf(var + EPS);
      bf16_t* op = rowb + (size_t)iq * INW + C_RG + head * 512 + 256 * hh + 4 * h;
#pragma unroll
      for (int eb = 0; eb < 8; ++eb)
#pragma unroll
          for (int g4 = 0; g4 < 4; ++g4) { bf16_t* pp = op + 32 * eb + 8 * g4; const u32x2 gq = *(const u32x2*)pp;
              u32x2 v; v.x = cvt_pk_bf16((o[eb][4 * g4 + 0] - mean) * rstd * bf_lo(gq.x), (o[eb][4 * g4 + 1] - mean) * rstd * bf_hi(gq.x));
              v.y = cvt_pk_bf16((o[eb][4 * g4 + 2] - mean) * rstd * bf_lo(gq.y), (o[eb][4 * g4 + 3] - mean) * rstd * bf_hi(gq.y));
              *(u32x2*)pp = v; } }
    __syncthreads();
}
}

DI void tr_item(const float* W, int K, int N, bf16_t* WT, int mode, LAS float* scr, int item, int lane) {
    const int nblk = N / 32, kb = item / nblk, nb = item % nblk, k0 = 64 * kb, n0 = 32 * nb;
    int rowbase = n0;
    if (mode) { const int which = n0 / FF, j = n0 - which * FF; rowbase = 256 * (j / 128) + 128 * which + (j % 128); }
#pragma unroll 8
    for (int i = 0; i < 32; ++i) { const int kk = 2 * i + (lane >> 5); scr[kk * 33 + (lane & 31)] = W[(size_t)(k0 + kk) * N + n0 + (lane & 31)]; }
    asm volatile("s_waitcnt lgkmcnt(0)" ::: "memory");
    const int c = lane & 7;
#pragma unroll
    for (int j = 0; j < 4; ++j) { const int n = (lane >> 3) + 8 * j; const LAS float* s = scr + (8 * c) * 33 + n;
        u32x4 o; o.x = cvt_pk_bf16(s[0 * 33], s[1 * 33]); o.y = cvt_pk_bf16(s[2 * 33], s[3 * 33]); o.z = cvt_pk_bf16(s[4 * 33], s[5 * 33]); o.w = cvt_pk_bf16(s[6 * 33], s[7 * 33]);
        *(u32x4*)(WT + (size_t)(rowbase + n) * K + k0 + 8 * c) = o; }
    asm volatile("s_waitcnt lgkmcnt(0)" ::: "memory");
}
DI void modulate_rows(const float* X, const float* g, const float* modsub, bf16_t* H, int ngw, const int wid) {
    const int lane = olane(), gw = opqi(blockIdx.x * 8 + wid);
    for (int m = gw; m < M; m += ngw) {
        const float* shift = modsub + (size_t)(m >> 11) * NMOD; const float* scale = shift + D;
        const f32x4* xr = (const f32x4*)(X + (size_t)m * D) + lane;
        f32x4 v[4]; float ss = 0.f;
#pragma unroll
        for (int j = 0; j < 4; ++j) { v[j] = xr[64 * j]; ss += (v[j].x * v[j].x + v[j].y * v[j].y) + (v[j].z * v[j].z + v[j].w * v[j].w); }
        const float rstd = __builtin_amdgcn_rsqf(wave_sum(ss) * (1.f / D) + EPS);
#pragma unroll
        for (int j = 0; j < 4; ++j) { const int k = 4 * (lane + 64 * j);
            const f32x4 gv = *(const f32x4*)(g + k), sc = *(const f32x4*)(scale + k), sh = *(const f32x4*)(shift + k);
            const f32x4 y = (v[j] * rstd * gv) * (sc + 1.f) + sh;
            u32x2 w; w.x = cvt_pk_bf16(y.x, y.y); w.y = cvt_pk_bf16(y.z, y.w);
            *(u32x2*)(H + (size_t)m * D + k) = w; }
    }
}

#define XB_TMO      128
#define XB_XCNT(j)  (256  + 64 * (j))
#define XB_XSUB(j)  (1280 + 64 * (j))
#define XB_XGEN(j)  (2304 + 64 * (j))
#define XB_TOP      3328
#define XB_TOPGEN   3392
#define XCD_BAR_WORDS 3456
#define XB_SPIN_CAP (1u << 18)
DI unsigned xb_ld(unsigned* p)              { return __hip_atomic_load(p, __ATOMIC_RELAXED, __HIP_MEMORY_SCOPE_AGENT); }
DI unsigned xb_add(unsigned* p, unsigned v) { return __hip_atomic_fetch_add(p, v, __ATOMIC_RELAXED, __HIP_MEMORY_SCOPE_AGENT); }
DI unsigned xb_xcc_id() { return (unsigned)__builtin_amdgcn_s_getreg((3 << 11) | 20) & 0xFu; }
#define XB_SPIN(cond, bar) do { unsigned _sp = 0; while (cond) { __builtin_amdgcn_s_sleep(1); \
    if ((++_sp & 255u) == 0u) { if (xb_ld(&(bar)[XB_TMO])) break; if (_sp > XB_SPIN_CAP) { atomicAdd(&(bar)[XB_TMO], 1u); break; } } } } while (0)
struct XcdBarrier { unsigned* bar; unsigned x; volatile LAS unsigned* st; };
DI XcdBarrier xcd_barrier_post(unsigned* bar, volatile LAS unsigned* st, bool lead) {
    XcdBarrier b; b.bar = bar; b.x = xb_xcc_id(); b.st = st;
    if (lead) (void)xb_add(&bar[XB_XCNT(b.x)], 1u);
    return b;
}
DI void xcd_barrier_complete(unsigned* bar, unsigned x, unsigned& nloc, unsigned& nx) {
    const unsigned G = gridDim.x * gridDim.y * gridDim.z;
    unsigned sum, cnt, mine, sp = 0u;
    for (;;) {
        sum = 0u; cnt = 0u; mine = 0u;
#pragma unroll
        for (unsigned j = 0; j < 16; ++j) { const unsigned c = xb_ld(&bar[XB_XCNT(j)]); sum += c; cnt += (c > 0u) ? 1u : 0u; mine = (j == x) ? c : mine; }
        if (sum == G) break;
        __builtin_amdgcn_s_sleep(1);
        if ((++sp & 255u) == 0u) { if (xb_ld(&bar[XB_TMO])) break; if (sp > XB_SPIN_CAP) { atomicAdd(&bar[XB_TMO], 1u); break; } }
    }
    nloc = mine > 0u ? mine : 1u; nx = cnt > 0u ? cnt : 1u;
}
DI void xcd_barrier(const XcdBarrier& b, bool lead) {
    asm volatile("s_waitcnt vmcnt(0)" ::: "memory");
    __syncthreads();
    if (lead) {
        unsigned* bar = b.bar;
        __builtin_amdgcn_s_waitcnt(0);
        unsigned nloc = b.st[0], nx = b.st[1];
        if (nloc == 0u) { xcd_barrier_complete(bar, b.x, nloc, nx); b.st[0] = nloc; b.st[1] = nx; }
        const unsigned old = xb_add(&bar[XB_XSUB(b.x)], 1u);
        const unsigned gen = old / nloc;
        if (old + 1u == (gen + 1u) * nloc) {
            __builtin_amdgcn_fence(__ATOMIC_RELEASE, "agent");
            asm volatile("s_waitcnt vmcnt(0)" ::: "memory");
            const unsigned og = xb_add(&bar[XB_TOP], 1u);
            const unsigned tg = og / nx;
            if (og + 1u == (tg + 1u) * nx) xb_add(&bar[XB_TOPGEN], 1u);
            else XB_SPIN(xb_ld(&bar[XB_TOPGEN]) == tg, bar);
            __builtin_amdgcn_fence(__ATOMIC_ACQUIRE, "agent");
            xb_add(&bar[XB_XGEN(b.x)], 1u);
            asm volatile("s_waitcnt vmcnt(0)" ::: "memory");
        } else {
            XB_SPIN(xb_ld(&bar[XB_XGEN(b.x)]) == gen, bar);
            __builtin_amdgcn_fence(__ATOMIC_ACQUIRE, "agent");
            asm volatile("s_waitcnt vmcnt(0)" ::: "memory");
        }
    }
    __syncthreads();
}

struct Args { const float* in[16]; float* out; unsigned char* ws; };

__global__ void __launch_bounds__(512, 2) mega(Args a) {
    extern __shared__ __attribute__((aligned(16))) unsigned char lds_raw[];
    LAS unsigned char* lds = (LAS unsigned char*)lds_raw;
    cg::grid_group grid = cg::this_grid();
    const int wid = __builtin_amdgcn_readfirstlane((int)threadIdx.x >> 6);
    const int G = gridDim.x, ngw = G * 8;
    unsigned char* ws = a.ws;
    const float* x_in = a.in[0];
    float* out = a.out;
#define mod ((float*)(opq(ws) + WS_MOD))
#define ctl ((unsigned*)(opq(ws) + WS_CTL))
#define W1I ((bf16_t*)(opq(ws) + WS_W1I))
#define W1O ((bf16_t*)(opq(ws) + WS_W1O))
#define WIN ((bf16_t*)(opq(ws) + WS_WIN))
#define WRO ((bf16_t*)(opq(ws) + WS_WRO))
#define WDO ((bf16_t*)(opq(ws) + WS_WDO))
#define WO ((bf16_t*)(opq(ws) + WS_WO))
#define H ((bf16_t*)(opq(ws) + WS_H))
#define BIG ((bf16_t*)(opq(ws) + WS_BIG))
    LAS unsigned* sflag = (LAS unsigned*)(lds + 131072);
    if (wid == 0) { const int l0 = olane(); if (l0 < 8) sflag[l0] = 0u; }
    __syncthreads();
    const XcdBarrier xbar = xcd_barrier_post((unsigned*)(ws + WS_BAR), (volatile LAS unsigned*)(sflag + 2), wid == 0 && olane() == 0);
#define GSYNC() xcd_barrier(xbar, wid == 0 && olane() == 0)

    for (int item = blockIdx.x; item < NMOD / 64; item += G) {
        const int lane = olane(), tid = wid * 64 + lane;
        LAS float* cs = (LAS float*)lds; LAS float* red = (LAS float*)(lds + 32768);
        for (int i = tid; i < NB * D; i += 512) cs[i] = siluf_(a.in[1][i]);
        __syncthreads();
        const int col = item * 64 + lane, k0 = wid * 128;
        float acc[8];
#pragma unroll
        for (int b = 0; b < 8; ++b) acc[b] = 0.f;
        const float* wp = a.in[2] + (size_t)k0 * NMOD + col;
#pragma unroll 8
        for (int k = 0; k < 128; ++k) { const float w = wp[(size_t)k * NMOD];
#pragma unroll
            for (int b = 0; b < 8; ++b) acc[b] += cs[b * D + k0 + k] * w; }
#pragma unroll
        for (int b = 0; b < 8; ++b) red[(wid * 8 + b) * 64 + lane] = acc[b];
        __syncthreads();
        { float s = 0.f;
#pragma unroll
          for (int w = 0; w < 8; ++w) s += red[(w * 8 + wid) * 64 + lane];
          mod[(size_t)wid * NMOD + col] = s + a.in[3][col]; }
        __syncthreads();
    }
    {
        const int lane = olane(), gw = opqi(blockIdx.x * 8 + wid);
        LAS float* scr = (LAS float*)(lds + wid * 16384);
        constexpr int I_FI = (D / 64) * (2 * FF / 32), I_FO = (FF / 64) * (D / 32), I_IN = (D / 64) * (INW / 32), I_RO = (2048 / 64) * (D / 32), I_DO = (D / 64) * (D / 32);
        constexpr int NIT = I_FI + I_FO + I_IN + I_RO + 2 * I_DO;
        for (int it = gw; it < NIT; it += ngw) {
            int r = it;
            if (r < I_FI) { tr_item(a.in[5], D, 2 * FF, W1I, 1, scr, r, lane); continue; } r -= I_FI;
            if (r < I_FO) { tr_item(a.in[6], FF, D, W1O, 0, scr, r, lane); continue; } r -= I_FO;
            if (r < I_IN) { tr_item(a.in[7], D, INW, WIN, 0, scr, r, lane); continue; } r -= I_IN;
            if (r < I_RO) { tr_item(a.in[8], 2048, D, WRO, 0, scr, r, lane); continue; } r -= I_RO;
            if (r < I_DO) { tr_item(a.in[11], D, D, WDO, 0, scr, r, lane); continue; } r -= I_DO;
            tr_item(a.in[12], D, D, WO, 0, scr, r, lane);
        }
    }
    grid.sync();

#pragma unroll 1
    for (int stage = 0; stage < 2; ++stage) {
        modulate_rows(stage == 0 ? x_in : out, a.in[4] + (stage == 0 ? 0 : 2 * D), mod + (stage == 0 ? 0 : 2 * 3 * D), H, ngw, wid);
        GSYNC();
        { pg8::Gemm g{H, W1I, M, 2 * FF, D, D, D}; pg8::StaticOrder S; S.init(M, 2 * FF, G, (int)blockIdx.x);
          pg8::EpiSwiglu E{BIG, FF};
          pg8::gemm_phase<pg8::EpiSwiglu, pg8::StaticOrder>(lds, g, S, E, wid); }
        GSYNC();
        { pg8::Gemm g{BIG, W1O, M, D, FF, FF, FF}; pg8::StaticOrder S; S.init(M, D, G, (int)blockIdx.x);
          pg8::EpiResid E{stage == 0 ? x_in : out, out, mod + (stage == 0 ? 0 : 2 * 3 * D) + 2 * D, 0.5f, 0};
          pg8::gemm_phase<pg8::EpiResid, pg8::StaticOrder>(lds, g, S, E, wid); }
        GSYNC();
        if (stage == 1) break;

        modulate_rows(out, a.in[4] + D, mod + 3 * D, H, ngw, wid);
        {
            const int lane = olane(), gw = opqi(blockIdx.x * 8 + wid);
            LAS float* scr = (LAS float*)(lds + wid * 16384);
            constexpr int I_FI = (D / 64) * (2 * FF / 32), I_FO = (FF / 64) * (D / 32);
            for (int it = gw; it < I_FI + I_FO; it += ngw) {
                if (it < I_FI) tr_item(a.in[13], D, 2 * FF, W1I, 1, scr, it, lane);
                else tr_item(a.in[14], FF, D, W1O, 0, scr, it - I_FI, lane);
            }
        }
        GSYNC();
        { const int lane = olane(); const float* lp = a.in[9]; const float s01 = wave_sum(lp[lane] * lp[64 + lane]), s23 = wave_sum(lp[128 + lane] * lp[192 + lane]);
          if (wid == 0 && lane == 0) ((LAS float*)sflag)[1] = __expf(s01) - __expf(s23) + 0.2f; }
#pragma unroll 1
        for (int grp = 0; grp < NB / GB; ++grp) {
            { pg8::Gemm g{H + (size_t)grp * MG * D, WIN, MG, INW, D, D, D}; pg8::StaticOrder S; S.init(MG, INW, G, (int)blockIdx.x);
              pg8::EpiProj E{BIG};
              pg8::gemm_phase<pg8::EpiProj, pg8::StaticOrder>(lds, g, S, E, wid); }
            GSYNC();
            for (;;) {
                if (wid == 0 && olane() == 0) sflag[0] = atomicAdd(ctl + 64 * grp, 1u);
                __syncthreads();
                const int u = (int)sflag[0];
                __syncthreads();
                if (u >= 256 + 512) break;
                if (u < 256) { const int qb = 15 - (u >> 4), bh = u & 15; att::ret_unit(lds, BIG, bh >> 2, bh & 3, qb, wid); }
                else { const int j = u - 256, qb = 15 - (j >> 5), bh = j & 31; att::diff_unit(lds, BIG, bh >> 3, bh & 7, qb, ((LAS float*)sflag)[1], a.in[10], wid); }
            }
            GSYNC();
            { pg8::StaticOrder S; S.init(MG, D, G, (int)blockIdx.x);
              { pg8::Gemm g{BIG + C_RG, WRO, MG, D, 2048, INW, 2048}; pg8::EpiY E{BIG, C_GT, 0}; pg8::gemm_phase<pg8::EpiY, pg8::StaticOrder>(lds, g, S, E, wid); }
              { pg8::Gemm g{BIG + C_DQ, WDO, MG, D, D, INW, D}; pg8::EpiY E{BIG, C_GT + D, 1}; pg8::gemm_phase<pg8::EpiY, pg8::StaticOrder>(lds, g, S, E, wid); } }
            GSYNC();
            { pg8::Gemm g{BIG, WO, MG, D, D, INW, D}; pg8::StaticOrder S; S.init(MG, D, G, (int)blockIdx.x);
              float* o2 = out + (size_t)grp * MG * D;
              pg8::EpiResid E{o2, o2, mod + 3 * D + 2 * D, 1.0f, grp * GB};
              pg8::gemm_phase<pg8::EpiResid, pg8::StaticOrder>(lds, g, S, E, wid); }
            GSYNC();
        }
    }
    const int lane = olane(), gw = opqi(blockIdx.x * 8 + wid);
    for (int m = gw; m < M; m += ngw) {
        f32x4* xr = (f32x4*)(out + (size_t)m * D) + lane;
        f32x4 v[4]; float ss = 0.f;
#pragma unroll
        for (int j = 0; j < 4; ++j) { v[j] = xr[64 * j]; ss += (v[j].x * v[j].x + v[j].y * v[j].y) + (v[j].z * v[j].z + v[j].w * v[j].w); }
        const float rstd = __builtin_amdgcn_rsqf(wave_sum(ss) * (1.f / D) + EPS);
#pragma unroll
        for (int j = 0; j < 4; ++j) { const f32x4 gv = *(const f32x4*)(a.in[15] + 4 * (lane + 64 * j)); xr[64 * j] = v[j] * rstd * gv; }
    }
}

extern "C" void kernel_launch(void* const* d_in, const int* in_sizes, int n_in, void* d_out, int out_size, void* d_ws, size_t ws_size, hipStream_t stream) {
    static int grid = 0;
    if (grid == 0) {
        if (n_in != 16 || out_size != M * D || ws_size < WS_END) { fprintf(stderr, "kernel_launch: unexpected problem (n_in %d out %d ws %zu)\n", n_in, out_size, ws_size); grid = -1; return; }
        int dev = 0, cus = 0, per_cu = 0;
        hipGetDevice(&dev); hipDeviceGetAttribute(&cus, hipDeviceAttributeMultiprocessorCount, dev);
        hipFuncSetAttribute((const void*)mega, hipFuncAttributeMaxDynamicSharedMemorySize, LDS_BYTES);
        hipOccupancyMaxActiveBlocksPerMultiprocessor(&per_cu, (const void*)mega, 512, LDS_BYTES);
        if (per_cu < 1) { fprintf(stderr, "kernel_launch: occupancy query says %d blocks per CU\n", per_cu); per_cu = 1; }
        grid = cus * 1;
    }
    if (grid < 0) return;
    hipMemsetAsync((char*)d_ws + WS_CTL, 0, CTL_ZERO, stream);
    Args a{};
    for (int i = 0; i < 16; ++i) a.in[i] = (const float*)d_in[i];
    a.out = (float*)d_out; a.ws = (unsigned char*)d_ws;
    void* args[] = {&a};
    hipError_t e = hipLaunchCooperativeKernel((const void*)mega, dim3(grid), dim3(512), args, LDS_BYTES, stream);
    if (e != hipSuccess) fprintf(stderr, "cooperative launch failed: %s (grid %d)\n", hipGetErrorString(e), grid);
}
```

```cpp
#include <hip/hip_runtime.h>
#include <hip/hip_cooperative_groups.h>
#include <cstdio>
#include <cstdint>
namespace cg = cooperative_groups;

#define LAS __attribute__((address_space(3)))
#define DI __device__ __forceinline__
typedef unsigned short bf16_t;
typedef short bf16x8 __attribute__((ext_vector_type(8)));
typedef float f32x4 __attribute__((ext_vector_type(4)));
typedef float f32x16 __attribute__((ext_vector_type(16)));
typedef unsigned u32x4 __attribute__((ext_vector_type(4)));
typedef unsigned u32x2 __attribute__((ext_vector_type(2)));
typedef short s16x4 __attribute__((ext_vector_type(4)));

constexpr int D = 1024, SEQ = 2048, NB = 8, M = NB * SEQ, FF = 2816, INW = 11264, NMOD = 9216;
constexpr int GB = 4, MG = GB * SEQ;
constexpr int C_RQ = 0, C_RK = 1024, C_RV = 2048, C_RG = 4096, C_DQ = 6144, C_DK = 7168, C_DV = 8192, C_GT = 9216;
constexpr float EPS = 1e-6f;
constexpr size_t MiB = 1u << 20;
constexpr size_t WS_CTL = 0, WS_BAR = 16384, CTL_ZERO = 65536, WS_MOD = 65536, WS_W1I = 1 * MiB, WS_W1O = 12 * MiB, WS_WIN = 18 * MiB, WS_WRO = 40 * MiB, WS_WDO = 44 * MiB, WS_WO = 46 * MiB,
                 WS_H = 48 * MiB, WS_BIG = 80 * MiB, WS_END = 256 * MiB;
constexpr int LDS_BYTES = 131072 + 256;

DI unsigned cvt_pk_bf16(float lo, float hi) { unsigned r; asm volatile("v_cvt_pk_bf16_f32 %0, %1, %2" : "=v"(r) : "v"(lo), "v"(hi)); return r; }
DI float bf_lo(unsigned w) { return __uint_as_float(w << 16); }
DI float bf_hi(unsigned w) { return __uint_as_float(w & 0xffff0000u); }
DI float sigmoidf_(float x) { return __builtin_amdgcn_rcpf(1.f + __expf(-x)); }
DI float siluf_(float x) { return x * sigmoidf_(x); }
DI unsigned char* opq(unsigned char* p) { asm volatile("" : "+s"(p)); return p; }
DI unsigned opqv(unsigned v) { asm volatile("" : "+v"(v)); return v; }
DI f32x16 zero16() { float z = 0.f; asm volatile("" : "+v"(z)); f32x16 r; _Pragma("unroll") for (int i = 0; i < 16; ++i) r[i] = z; return r; }
DI int opqi(int v) { asm volatile("" : "+s"(v)); return v; }
DI int olane() { int l; asm volatile("v_mbcnt_lo_u32_b32 %0, -1, 0\n\tv_mbcnt_hi_u32_b32 %0, -1, %0" : "=v"(l)); return l; }
DI float wave_sum(float v) {
    const int l = olane();
#pragma unroll
    for (int o = 1; o < 64; o <<= 1) v += __uint_as_float(__builtin_amdgcn_ds_bpermute((l ^ o) << 2, __float_as_uint(v)));
    return v;
}
DI float xhalf_sum(float v) { auto rr = __builtin_amdgcn_permlane32_swap(__float_as_uint(v), __float_as_uint(v), false, false); return __uint_as_float(rr[0]) + __uint_as_float(rr[1]); }
DI float xhalf_max(float v) { auto rr = __builtin_amdgcn_permlane32_swap(__float_as_uint(v), __float_as_uint(v), false, false); return fmaxf(__uint_as_float(rr[0]), __uint_as_float(rr[1])); }

namespace pg8 {
constexpr int BM = 256, BK = 64, HALF = 128, HTB = HALF * BK * 2, STAGE_BYTES = 8 * HTB, NXCD = 8, WGM = 8;
__host__ __device__ __forceinline__ int lds_byte(int r, int c) { const int st = (r >> 4) * 2 + (c >> 5), rr = r & 15, cc = c & 31, ob = rr * 64 + cc * 2; return st * 1024 + (ob ^ (((ob >> 9) & 1) << 5)); }
__host__ __device__ __forceinline__ void stage_rc(int b, int& R, int& C) { const int st = b / 1024, sb = b % 1024, swz = sb ^ (((sb >> 9) & 1) << 5); R = (st >> 1) * 16 + swz / 64; C = (st & 1) * 32 + (swz % 64) / 2; }
__host__ __device__ __forceinline__ int perm32(int rho) { const int n = rho >> 4, i = rho & 15; return 8 * (i >> 2) + 4 * n + (i & 3); }

struct Unit { int pm, pn; };
struct Gemm { const bf16_t* A; const bf16_t* Bt; int M, N, K, lda, ldb; };

struct StaticOrder {
    int nM, nN, nwg, G, c;
    __host__ __device__ void init(int M_, int N_, int G_, int c_) { nM = M_ / BM; nN = N_ / BM; nwg = nM * nN; G = G_; c = c_; }
    __host__ __device__ bool next(int i, Unit& u) const {
        const long L = (long)i * G + c; if (L >= nwg) return false;
        int wgid = (int)L; { const int q = nwg / NXCD, r = nwg % NXCD, xcd = wgid % NXCD, off = wgid / NXCD; wgid = (xcd < r ? xcd * (q + 1) : r * (q + 1) + (xcd - r) * q) + off; }
        const int nig = WGM * nN, gid = wgid / nig, fm = gid * WGM, gsz = (nM - fm) < WGM ? (nM - fm) : WGM;
        u.pm = fm + ((wgid % nig) % gsz); u.pn = (wgid % nig) / gsz; return true;
    }
};


struct EpiSwiglu {
    static constexpr bool PERM = true;
    bf16_t* U; int ldc;
    DI void operator()(const f32x4 (&acc)[2][2][4][2], const Unit& u, int wr, int wc, int fr, int fq) const {
        const int row0 = u.pm * BM + wr * 64 + fr, col0 = u.pn * 128 + wc * 32 + 8 * fq;
#pragma unroll
        for (int ai = 0; ai < 2; ++ai)
#pragma unroll
            for (int m = 0; m < 4; ++m) {
                bf16_t* rowp = U + (size_t)(row0 + ai * HALF + m * 16) * ldc + col0;
                const f32x4 a0 = acc[ai][0][m][0], a1 = acc[ai][0][m][1], b0 = acc[ai][1][m][0], b1 = acc[ai][1][m][1];
                float v[8];
#pragma unroll
                for (int i = 0; i < 4; ++i) { v[i] = siluf_(a0[i]) * b0[i]; v[4 + i] = siluf_(a1[i]) * b1[i]; }
                u32x4 w; w.x = cvt_pk_bf16(v[0], v[1]); w.y = cvt_pk_bf16(v[2], v[3]); w.z = cvt_pk_bf16(v[4], v[5]); w.w = cvt_pk_bf16(v[6], v[7]);
                *(u32x4*)rowp = w;
            }
    }
};
struct EpiResid {
    static constexpr bool PERM = false;
    const float* base; float* out; const float* gate; float coef; int b0;
    DI void operator()(const f32x4 (&acc)[2][2][4][2], const Unit& u, int wr, int wc, int fr, int fq) const {
        const int row0 = u.pm * BM + wr * 64 + fr, col0 = u.pn * BM + wc * 32 + 4 * fq;
        const float* gp = gate + (size_t)(b0 + (u.pm >> 3)) * NMOD + col0;
        f32x4 gv[2][2];
#pragma unroll
        for (int bj = 0; bj < 2; ++bj)
#pragma unroll
            for (int n = 0; n < 2; ++n) gv[bj][n] = *(const f32x4*)(gp + bj * HALF + n * 16) * coef;
#pragma unroll
        for (int ai = 0; ai < 2; ++ai)
#pragma unroll
            for (int m = 0; m < 4; ++m) {
                const size_t off = (size_t)(row0 + ai * HALF + m * 16) * D + col0;
#pragma unroll
                for (int bj = 0; bj < 2; ++bj)
#pragma unroll
                    for (int n = 0; n < 2; ++n) { const f32x4 x = *(const f32x4*)(base + off + bj * HALF + n * 16); *(f32x4*)(out + off + bj * HALF + n * 16) = x + gv[bj][n] * acc[ai][bj][m][n]; }
            }
    }
};
struct EpiProj {
    static constexpr bool PERM = true;
    bf16_t* P;
    DI void operator()(const f32x4 (&acc)[2][2][4][2], const Unit& u, int wr, int wc, int fr, int fq) const {
        const int row0 = u.pm * BM + wr * 64 + fr, col0 = u.pn * BM + wc * 32 + 8 * fq;
        const int t = u.pn >> 2; const int act = (t == 1) ? 1 : ((t == 4 || t == 5) ? 2 : ((t >= 9) ? 3 : ((t == 6) ? 4 : 0)));
        const float lgh = __builtin_amdgcn_logf(1.f - __builtin_amdgcn_exp2f(-5.f - (float)(u.pn & 3)));
#pragma unroll
        for (int ai = 0; ai < 2; ++ai)
#pragma unroll
            for (int m = 0; m < 4; ++m) {
                bf16_t* rowp = P + (size_t)(row0 + ai * HALF + m * 16) * INW + col0;
#pragma unroll
                for (int bj = 0; bj < 2; ++bj) {
                    f32x4 v0 = acc[ai][bj][m][0], v1 = acc[ai][bj][m][1];
                    if (act == 1) { const float f = 0.0625f * __builtin_amdgcn_exp2f(lgh * (float)(31 - ((row0 + m * 16) & 31))); v0 = v0 * f; v1 = v1 * f; }
                    else if (act == 4) { v0 = v0 * 0.18033688011112042f; v1 = v1 * 0.18033688011112042f; }
                    else if (act == 2) {
#pragma unroll
                        for (int i = 0; i < 4; ++i) { v0[i] = siluf_(v0[i]); v1[i] = siluf_(v1[i]); } }
                    else if (act == 3) {
#pragma unroll
                        for (int i = 0; i < 4; ++i) { v0[i] = sigmoidf_(v0[i]); v1[i] = sigmoidf_(v1[i]); } }
                    u32x4 w; w.x = cvt_pk_bf16(v0[0], v0[1]); w.y = cvt_pk_bf16(v0[2], v0[3]); w.z = cvt_pk_bf16(v1[0], v1[1]); w.w = cvt_pk_bf16(v1[2], v1[3]);
                    *(u32x4*)(rowp + bj * HALF) = w;
                }
            }
    }
};
struct EpiY {
    static constexpr bool PERM = true;
    bf16_t* P; int gcol; int add;
    DI void operator()(const f32x4 (&acc)[2][2][4][2], const Unit& u, int wr, int wc, int fr, int fq) const {
        const int row0 = u.pm * BM + wr * 64 + fr, col0 = u.pn * BM + wc * 32 + 8 * fq;
#pragma unroll
        for (int ai = 0; ai < 2; ++ai)
#pragma unroll
            for (int m = 0; m < 4; ++m) {
                bf16_t* rowp = P + (size_t)(row0 + ai * HALF + m * 16) * INW + col0;
#pragma unroll
                for (int bj = 0; bj < 2; ++bj) {
                    const f32x4 v0 = acc[ai][bj][m][0], v1 = acc[ai][bj][m][1];
                    const u32x4 g = *(const u32x4*)(rowp + gcol + bj * HALF);
                    float o[8];
                    o[0] = bf_lo(g.x) * v0[0]; o[1] = bf_hi(g.x) * v0[1]; o[2] = bf_lo(g.y) * v0[2]; o[3] = bf_hi(g.y) * v0[3];
                    o[4] = bf_lo(g.z) * v1[0]; o[5] = bf_hi(g.z) * v1[1]; o[6] = bf_lo(g.w) * v1[2]; o[7] = bf_hi(g.w) * v1[3];
                    if (add) { const u32x4 y = *(const u32x4*)(rowp + bj * HALF);
                        o[0] += bf_lo(y.x); o[1] += bf_hi(y.x); o[2] += bf_lo(y.y); o[3] += bf_hi(y.y); o[4] += bf_lo(y.z); o[5] += bf_hi(y.z); o[6] += bf_lo(y.w); o[7] += bf_hi(y.w); }
                    u32x4 w; w.x = cvt_pk_bf16(o[0], o[1]); w.y = cvt_pk_bf16(o[2], o[3]); w.z = cvt_pk_bf16(o[4], o[5]); w.w = cvt_pk_bf16(o[6], o[7]);
                    *(u32x4*)(rowp + bj * HALF) = w;
                }
            }
    }
};

template <class Epi, class Sched>
DI void gemm_phase(LAS unsigned char* lds, const Gemm g, const Sched& S, const Epi& E, const int wid) {
    const int lane = olane(), tid = wid * 64 + lane, wr = wid >> 2, wc = wid & 3, fr = lane & 15, fq = lane >> 4;
    const int K = g.K, nt = K / BK;
    unsigned voffA[2], voffB[2];
#pragma unroll
    for (int i = 0; i < 2; ++i) { int R, C; stage_rc(tid * 16 + i * 8192, R, C); const int Rb = Epi::PERM ? ((R & ~31) + perm32(R & 31)) : R;
        voffA[i] = (unsigned)(R * g.lda + C) * 2u; voffB[i] = (unsigned)(Rb * g.ldb + C) * 2u; }
    const size_t kstep = (size_t)(BK * 2);
    const size_t hsA = (size_t)HALF * g.lda * 2, hsB = (size_t)HALF * g.ldb * 2;
    const size_t tsA = 2 * hsA, tsB = 2 * hsB;
    const unsigned ldsw = (unsigned)wid * 1024u;
    const int aoff = lds_byte(wr * 64 + fr, fq * 8), boff = lds_byte(wc * 32 + fr, fq * 8);
#define PG8_SA(b, h) (((b) * 2 + (h)) * HTB)
#define PG8_SB(b, h) ((4 + (b) * 2 + (h)) * HTB)
#define PG8_STAGE(bufoff, gbase, voff) do { _Pragma("unroll") for (int _i = 0; _i < 2; ++_i) \
        __builtin_amdgcn_global_load_lds((const unsigned*)((const char*)(gbase) + (voff)[_i]), (LAS unsigned*)(lds + (bufoff) + ldsw + _i * 8192), 16, 0, 0); } while (0)
#define PG8_LDA(dst, b, h) do { _Pragma("unroll") for (int m = 0; m < 4; ++m) _Pragma("unroll") for (int k = 0; k < 2; ++k) dst[m][k] = *(const LAS bf16x8*)(lds + PG8_SA(b, h) + aoff + m * 2048 + k * 1024); } while (0)
#define PG8_LDB(dst, b, h) do { _Pragma("unroll") for (int n = 0; n < 2; ++n) _Pragma("unroll") for (int k = 0; k < 2; ++k) dst[n][k] = *(const LAS bf16x8*)(lds + PG8_SB(b, h) + boff + n * 2048 + k * 1024); } while (0)
#define PG8_MMA(ai, bj, At, Bt) do { __builtin_amdgcn_s_setprio(1); _Pragma("unroll") for (int m = 0; m < 4; ++m) _Pragma("unroll") for (int n = 0; n < 2; ++n) _Pragma("unroll") for (int k = 0; k < 2; ++k) \
        acc[ai][bj][m][n] = __builtin_amdgcn_mfma_f32_16x16x32_bf16(Bt[n][k], At[m][k], acc[ai][bj][m][n], 0, 0, 0); __builtin_amdgcn_s_setprio(0); } while (0)
#define PG8_WAIT_V(n) asm volatile("s_waitcnt vmcnt(" #n ")" ::: "memory")
#define PG8_WAIT_L(n) asm volatile("s_waitcnt lgkmcnt(" #n ")" ::: "memory")
#define PG8_BAR __builtin_amdgcn_s_barrier()
#define PG8_SCHED __builtin_amdgcn_sched_barrier(0)
    Unit cur, nxt; int ui = 0;
    if (!S.next(0, cur)) return;
    f32x4 acc[2][2][4][2];
#pragma unroll
    for (int a = 0; a < 2; ++a)
#pragma unroll
        for (int b = 0; b < 2; ++b)
#pragma unroll
            for (int m = 0; m < 4; ++m)
#pragma unroll
                for (int n = 0; n < 2; ++n) acc[a][b][m][n] = (f32x4){0.f, 0.f, 0.f, 0.f};
    bf16x8 At[4][2], B0[2][2], B1[2][2];
    const char* cA = (const char*)g.A + (size_t)cur.pm * tsA; const char* cB = (const char*)g.Bt + (size_t)cur.pn * tsB;
    PG8_STAGE(PG8_SB(0, 0), cB, voffB); PG8_STAGE(PG8_SB(0, 1), cB + hsB, voffB); PG8_STAGE(PG8_SA(0, 0), cA, voffA); PG8_STAGE(PG8_SA(0, 1), cA + hsA, voffA);
    if (wr == 1) PG8_BAR;
    PG8_WAIT_V(2); PG8_BAR;
    PG8_STAGE(PG8_SB(1, 0), cB + kstep, voffB); PG8_STAGE(PG8_SA(1, 0), cA + kstep, voffA); PG8_STAGE(PG8_SB(1, 1), cB + hsB + kstep, voffB);
    PG8_WAIT_V(6); PG8_BAR;
    for (;;) {
        const bool has_next = S.next(ui + 1, nxt);
        const char* nA = has_next ? (const char*)g.A + (size_t)nxt.pm * tsA : cA; const char* nB = has_next ? (const char*)g.Bt + (size_t)nxt.pn * tsB : cB;
        for (int t = 0; t < nt; t += 2) {
            const bool last = (t == nt - 2);
            const char* a1 = cA + (size_t)(t + 1) * kstep;
            const char* a2 = last ? nA : cA + (size_t)(t + 2) * kstep; const char* b2 = last ? nB : cB + (size_t)(t + 2) * kstep;
            const char* a3 = a2 + kstep; const char* b3 = b2 + kstep;
            PG8_LDB(B0, 0, 0); PG8_LDB(B1, 0, 1); PG8_SCHED; PG8_LDA(At, 0, 0); PG8_STAGE(PG8_SA(1, 1), a1 + hsA, voffA);
            PG8_WAIT_V(8); PG8_WAIT_L(0); PG8_BAR; PG8_MMA(0, 0, At, B0); PG8_MMA(0, 1, At, B1); PG8_BAR; PG8_SCHED;
            PG8_LDA(At, 0, 1); PG8_STAGE(PG8_SB(0, 0), b2, voffB); PG8_STAGE(PG8_SB(0, 1), b2 + hsB, voffB); PG8_STAGE(PG8_SA(0, 0), a2, voffA);
            PG8_WAIT_V(8); PG8_WAIT_L(0); PG8_BAR; PG8_MMA(1, 0, At, B0); PG8_MMA(1, 1, At, B1); PG8_BAR; PG8_SCHED;
            PG8_LDB(B0, 1, 0); PG8_LDB(B1, 1, 1); PG8_SCHED; PG8_LDA(At, 1, 0); PG8_STAGE(PG8_SA(0, 1), a2 + hsA, voffA);
            PG8_WAIT_V(8); PG8_WAIT_L(0); PG8_BAR; PG8_MMA(0, 0, At, B0); PG8_MMA(0, 1, At, B1); PG8_BAR; PG8_SCHED;
            PG8_LDA(At, 1, 1); PG8_STAGE(PG8_SB(1, 0), b3, voffB); PG8_STAGE(PG8_SB(1, 1), b3 + hsB, voffB); PG8_STAGE(PG8_SA(1, 0), a3, voffA);
            PG8_WAIT_V(8); PG8_WAIT_L(0); PG8_BAR; PG8_MMA(1, 0, At, B0); PG8_MMA(1, 1, At, B1); PG8_BAR; PG8_SCHED;
        }
        if (wr == 0) PG8_BAR;
        E(acc, cur, wr, wc, fr, fq);
        if (!has_next) break;
#pragma unroll
        for (int a = 0; a < 2; ++a)
#pragma unroll
            for (int b = 0; b < 2; ++b)
#pragma unroll
                for (int m = 0; m < 4; ++m)
#pragma unroll
                    for (int n = 0; n < 2; ++n) acc[a][b][m][n] = (f32x4){0.f, 0.f, 0.f, 0.f};
        cur = nxt; cA = nA; cB = nB; ++ui;
        if (wr == 1) PG8_BAR;
    }
    PG8_WAIT_V(0);
    PG8_BAR;
#undef PG8_SA
#undef PG8_SB
#undef PG8_STAGE
#undef PG8_LDA
#undef PG8_LDB
#undef PG8_MMA
#undef PG8_WAIT_V
#undef PG8_WAIT_L
#undef PG8_BAR
#undef PG8_SCHED
}
}

namespace att {
typedef short v4i16_t __attribute__((ext_vector_type(4)));
DI int fsw(int row) { return ((row & 3) << 2) | ((row >> 2) & 3); }
DI s16x4 vtr(LAS const unsigned char* p) { return __builtin_bit_cast(s16x4, __builtin_amdgcn_ds_read_tr16_b64_v4i16((LAS v4i16_t*)p)); }
DI void dma16(const void* g, LAS unsigned char* l) { __builtin_amdgcn_global_load_lds((const unsigned*)g, (LAS unsigned*)l, 16, 0, 0); }
#define MFMA32(a, b, c) __builtin_amdgcn_mfma_f32_32x32x16_bf16((a), (b), (c), 0, 0, 0)
DI bf16x8 pack8(const f32x16& x, int s8) {
    u32x4 p; p.x = cvt_pk_bf16(x[s8 + 0], x[s8 + 1]); p.y = cvt_pk_bf16(x[s8 + 2], x[s8 + 3]); p.z = cvt_pk_bf16(x[s8 + 4], x[s8 + 5]); p.w = cvt_pk_bf16(x[s8 + 6], x[s8 + 7]);
    return __builtin_bit_cast(bf16x8, p);
}
#define WAITV0() asm volatile("s_waitcnt vmcnt(0)" ::: "memory")

template <bool DIAG>
DI void diff_tile(f32x16 (&o)[4], float& mrun, float& lrun, bool& first, const bf16x8 (&qf)[4], LAS unsigned char* lds, const int bufi, const unsigned K0, const unsigned V0a, const unsigned V0b,
                  const int t, const int iq, const int h, const int q0, const float c2, const float c2x5) {
#define DV_LOAD(L, Hh, g_) do { _Pragma("unroll") for (int e2 = 0; e2 < 2; ++e2) { L[e2] = vtr((LAS const unsigned char*)(size_t)(va0 ^ (64 * (2 * ((g_) & 1) + e2))) + 4096 * ((g_) >> 1)); Hh[e2] = vtr((LAS const unsigned char*)(size_t)(va1 ^ (64 * (2 * ((g_) & 1) + e2))) + 4096 * ((g_) >> 1)); } } while (0)
#define DV_MMA(L, Hh, g_) do { _Pragma("unroll") for (int e2 = 0; e2 < 2; ++e2) { const bf16x8 vf = __builtin_shufflevector(L[e2], Hh[e2], 0, 1, 2, 3, 4, 5, 6, 7); o[2 * ((g_) & 1) + e2] = MFMA32(vf, pf[(g_) >> 1], o[2 * ((g_) & 1) + e2]); } } while (0)
            const unsigned kbase = (unsigned)(size_t)lds + (bufi) * 32768;
            const unsigned ka = opqv(kbase + K0), va0 = opqv(kbase + 16384 + V0a), va1 = opqv(kbase + 16384 + V0b);
            const float base = (float)(64 * t + 4 * h - iq) * c2 - mrun;
            f32x16 st[2];
            { float bv = base;
#pragma unroll
              for (int kb = 0; kb < 2; ++kb)
#pragma unroll
                  for (int i = 0; i < 16; ++i) { st[kb][i] = bv; bv += ((i & 3) == 3) ? c2x5 : c2; } }
            { bf16x8 kf[8];
#pragma unroll
              for (int kb = 0; kb < 2; ++kb)
#pragma unroll
                  for (int ks = 0; ks < 4; ++ks) kf[kb * 4 + ks] = *(const LAS bf16x8*)((size_t)(ka ^ (32 * ks)) + kb * 8192);
              __builtin_amdgcn_sched_barrier(0);
#pragma unroll
              for (int ks = 0; ks < 4; ++ks)
#pragma unroll
                  for (int kb = 0; kb < 2; ++kb) st[kb] = MFMA32(kf[kb * 4 + ks], qf[ks], st[kb]); }
            s16x4 vl0[2], vh0[2], vl1[2], vh1[2];
            __builtin_amdgcn_sched_barrier(0);
            DV_LOAD(vl0, vh0, 0);
            __builtin_amdgcn_sched_barrier(0);
            if (DIAG && 64 * t + 63 > q0) {
                const int lim = iq - 64 * t - 4 * h;
#pragma unroll
                for (int kb = 0; kb < 2; ++kb)
#pragma unroll
                    for (int i = 0; i < 16; ++i) if (32 * kb + (i & 3) + 8 * (i >> 2) > lim) st[kb][i] = -INFINITY;
            }
            float mx = fmaxf(st[0][0], st[1][0]);
#pragma unroll
            for (int i = 1; i < 16; ++i) mx = fmaxf(mx, fmaxf(st[0][i], st[1][i]));
            mx = xhalf_max(mx);
            if (DIAG && first) {
                first = false; mrun = mx;
#pragma unroll
                for (int kb = 0; kb < 2; ++kb)
#pragma unroll
                    for (int i = 0; i < 16; ++i) st[kb][i] -= mx;
            } else if (__any(mx > 5.f)) {
                const float dl = fmaxf(mx, 0.f), alpha = __builtin_amdgcn_exp2f(-dl);
                mrun += dl; lrun *= alpha;
#pragma unroll
                for (int kb = 0; kb < 2; ++kb)
#pragma unroll
                    for (int i = 0; i < 16; ++i) st[kb][i] -= dl;
#pragma unroll
                for (int eb = 0; eb < 4; ++eb) o[eb] = o[eb] * alpha;
            }
            float ls = 0.f;
#pragma unroll
            for (int kb = 0; kb < 2; ++kb)
#pragma unroll
                for (int i = 0; i < 16; ++i) { const float p = __builtin_amdgcn_exp2f(st[kb][i]); st[kb][i] = p; ls += p; }
            lrun += ls;
            bf16x8 pf[4];
#pragma unroll
            for (int s = 0; s < 4; ++s) pf[s] = pack8(st[s >> 1], 8 * (s & 1));
            __builtin_amdgcn_sched_barrier(0);
            DV_LOAD(vl1, vh1, 1); __builtin_amdgcn_sched_barrier(0); DV_MMA(vl0, vh0, 0); __builtin_amdgcn_sched_barrier(0);
            DV_LOAD(vl0, vh0, 2); __builtin_amdgcn_sched_barrier(0); DV_MMA(vl1, vh1, 1); __builtin_amdgcn_sched_barrier(0);
            DV_LOAD(vl1, vh1, 3); __builtin_amdgcn_sched_barrier(0); DV_MMA(vl0, vh0, 2); __builtin_amdgcn_sched_barrier(0);
            DV_LOAD(vl0, vh0, 4); __builtin_amdgcn_sched_barrier(0); DV_MMA(vl1, vh1, 3); __builtin_amdgcn_sched_barrier(0);
            DV_LOAD(vl1, vh1, 5); __builtin_amdgcn_sched_barrier(0); DV_MMA(vl0, vh0, 4); __builtin_amdgcn_sched_barrier(0);
            DV_LOAD(vl0, vh0, 6); __builtin_amdgcn_sched_barrier(0); DV_MMA(vl1, vh1, 5); __builtin_amdgcn_sched_barrier(0);
            DV_LOAD(vl1, vh1, 7); __builtin_amdgcn_sched_barrier(0); DV_MMA(vl0, vh0, 6); __builtin_amdgcn_sched_barrier(0);
            DV_MMA(vl1, vh1, 7);
#undef DV_LOAD
#undef DV_MMA
}
DI void diff_unit(LAS unsigned char* lds, bf16_t* P, int b, int head, int qb, const LAS float* lamp, const float* subln, const int wid) {
    const int lane = olane(), r = lane & 31, h = lane >> 5;
    const int mp = wid >> 2, qg = wid & 3, q0 = 128 * qb + 32 * qg, iq = q0 + r;
    bf16_t* rowb = P + (size_t)b * SEQ * INW;
    bf16x8 qf[4];
    { const bf16_t* qp = rowb + (size_t)iq * INW + C_DQ + head * 128 + mp * 64 + 8 * h;
#pragma unroll
      for (int ks = 0; ks < 4; ++ks) qf[ks] = *(const bf16x8*)(qp + 16 * ks); }
    const int NT = 2 * (qb + 1);
    unsigned koff[2], voff[2];
#pragma unroll
    for (int i = 0; i < 2; ++i) { const int L = wid * 2 + i, row = 4 * L + (lane >> 4), p = lane & 15, ch = p ^ fsw(row);
        koff[i] = (unsigned)(row * INW + C_DK + head * 128 + ch * 8) * 2u; voff[i] = (unsigned)(row * INW + C_DV + head * 128 + ch * 8) * 2u; }
    const char* gb = (const char*)rowb;
    const float slope = __builtin_amdgcn_exp2f(-(float)(head + 1));
    const float c2 = slope * 1.4426950408889634f, c2x5 = 5.f * c2;
    const int fr_ = fsw(r);
    const unsigned K0 = 256 * r + 16 * ((8 * mp + h) ^ fr_);
    const int i16 = lane & 15, q4 = i16 >> 2, p4 = i16 & 3, gg = (lane >> 4) & 1;
    int vlow[2], ebx[4];
#pragma unroll
    for (int jh = 0; jh < 2; ++jh) vlow[jh] = 256 * (8 * jh + 4 * h + q4) + 16 * ((2 * gg + (p4 >> 1)) ^ (2 * jh + h)) + 8 * (p4 & 1);
#pragma unroll
    for (int eb = 0; eb < 4; ++eb) ebx[eb] = 64 * (eb ^ q4);
    const unsigned V0a = vlow[0] + 64 * q4, V0b = vlow[1] + 64 * q4;
    f32x16 o[4];
#pragma unroll
    for (int eb = 0; eb < 4; ++eb) o[eb] = zero16();
    float mrun = 0.f, lrun = 0.f; bool first = true;
#define DIFF_DMA(t, bi) do { const char* src_ = gb + (size_t)(t) * 64 * INW * 2; _Pragma("unroll") for (int i_ = 0; i_ < 2; ++i_) { \
        dma16(src_ + koff[i_], lds + (bi) * 32768 + (wid * 2 + i_) * 1024); dma16(src_ + voff[i_], lds + (bi) * 32768 + 16384 + (wid * 2 + i_) * 1024); } } while (0)
    WAITV0();
    DIFF_DMA(NT - 1, 0); DIFF_DMA(NT - 2, 1); if (NT > 2) DIFF_DMA(NT - 3, 2);
    for (int it = 0; it < 2; ++it) {
        const int t = NT - 1 - it;
        if (it + 2 < NT) asm volatile("s_waitcnt vmcnt(8)\n\ts_barrier" ::: "memory");
        else if (it + 1 < NT) asm volatile("s_waitcnt vmcnt(4)\n\ts_barrier" ::: "memory");
        else asm volatile("s_waitcnt vmcnt(0)\n\ts_barrier" ::: "memory");
        if (it + 3 < NT) DIFF_DMA(t - 3, (it + 3) & 3);
        if (64 * t <= q0 + 31) diff_tile<true>(o, mrun, lrun, first, qf, lds, it & 3, K0, V0a, V0b, t, iq, h, q0, c2, c2x5);
    }
    for (int it = 2; it < NT; ++it) {
        const int t = NT - 1 - it;
        if (it + 2 < NT) asm volatile("s_waitcnt vmcnt(8)\n\ts_barrier" ::: "memory");
        else if (it + 1 < NT) asm volatile("s_waitcnt vmcnt(4)\n\ts_barrier" ::: "memory");
        else asm volatile("s_waitcnt vmcnt(0)\n\ts_barrier" ::: "memory");
        if (it + 3 < NT) DIFF_DMA(t - 3, (it + 3) & 3);
        diff_tile<false>(o, mrun, lrun, first, qf, lds, it & 3, K0, V0a, V0b, t, iq, h, q0, c2, c2x5);
    }
#undef DIFF_DMA
    { const float lt = xhalf_sum(lrun), inv = 1.f / lt;
#pragma unroll
      for (int eb = 0; eb < 4; ++eb) o[eb] = o[eb] * inv; }
    __syncthreads();
    LAS float* X = (LAS float*)(lds + qg * 16384);
    const int lane3 = olane();
    if (mp == 1) {
#pragma unroll
        for (int eb = 0; eb < 4; ++eb)
#pragma unroll
            for (int i = 0; i < 16; ++i) X[(eb * 16 + i) * 64 + lane3] = o[eb][i];
    }
    __syncthreads();
    if (mp == 0) {
        const int lane2 = olane(), h2 = lane2 >> 5, iq2 = q0 + (lane2 & 31);
        const float lam = lamp[0];
        float ss = 0.f;
#pragma unroll
        for (int eb = 0; eb < 4; ++eb)
#pragma unroll
            for (int i = 0; i < 16; ++i) { const float d = o[eb][i] - lam * X[(eb * 16 + i) * 64 + lane2]; o[eb][i] = d; ss += d * d; }
        ss = xhalf_sum(ss);
        const float rs = __builtin_amdgcn_rsqf(ss * (1.f / 128.f) + EPS) * 0.8f;
        bf16_t* op = rowb + (size_t)iq2 * INW + C_DQ + head * 128 + 4 * h2;
#pragma unroll
        for (int eb = 0; eb < 4; ++eb)
#pragma unroll
            for (int g4 = 0; g4 < 4; ++g4) { const int e = 32 * eb + 8 * g4; const f32x4 w = *(const f32x4*)(subln + e + 4 * h2);
                u32x2 v; v.x = cvt_pk_bf16(o[eb][4 * g4 + 0] * rs * w[0], o[eb][4 * g4 + 1] * rs * w[1]); v.y = cvt_pk_bf16(o[eb][4 * g4 + 2] * rs * w[2], o[eb][4 * g4 + 3] * rs * w[3]);
                *(u32x2*)(op + e) = v; }
    }
    __syncthreads();
}

template <bool DIAG>
DI void ret_tile(f32x16 (&o)[8], const bf16x8 (&qf)[8], LAS unsigned char* lds, const int bufi, const unsigned K0, const unsigned V0a, const unsigned V0b, LAS float* XS, LAS const float* XP,
                 const int t, const int iq, const int h, const int q0, const float lg) {
#define RV_LOAD(L, Hh, g_) do { _Pragma("unroll") for (int e3 = 0; e3 < 4; ++e3) { L[e3] = vtr((LAS const unsigned char*)(size_t)(va0 ^ (64 * e3)) + 256 * ((g_) & 1) + 16384 * ((g_) >> 1)); Hh[e3] = vtr((LAS const unsigned char*)(size_t)(va1 ^ (64 * e3)) + 256 * ((g_) & 1) + 16384 * ((g_) >> 1)); } } while (0)
#define RV_MMA(L, Hh, g_) do { _Pragma("unroll") for (int e3 = 0; e3 < 4; ++e3) { const bf16x8 vf = __builtin_shufflevector(L[e3], Hh[e3], 0, 1, 2, 3, 4, 5, 6, 7); o[4 * ((g_) & 1) + e3] = MFMA32(vf, pf[(g_) >> 1], o[4 * ((g_) & 1) + e3]); } } while (0)
    const bool live = !DIAG || (32 * t <= q0 + 31);
    const unsigned kbase = (unsigned)(size_t)lds + bufi * 49152;
    const unsigned ka = opqv(kbase + K0), va0 = opqv(kbase + 16384 + V0a), va1 = opqv(kbase + 16384 + V0b);
    f32x16 st = zero16();
    if (live) {
        { bf16x8 kf[8];
#pragma unroll
          for (int ks = 0; ks < 8; ++ks) kf[ks] = *(const LAS bf16x8*)(size_t)(ka ^ (32 * ks));
          __builtin_amdgcn_sched_barrier(0);
#pragma unroll
          for (int ks = 0; ks < 8; ++ks) st = MFMA32(kf[ks], qf[ks], st); }
#pragma unroll
        for (int i = 0; i < 16; ++i) XS[i * 64] = st[i];
    }
    __syncthreads();
    if (live) {
#pragma unroll
        for (int i = 0; i < 16; ++i) st[i] += XP[i * 64];
        const float rowf = __builtin_amdgcn_exp2f(lg * (float)(iq - 32 * t - 31));
#pragma unroll
        for (int i = 0; i < 16; ++i) st[i] *= rowf;
        if (DIAG && 32 * t + 31 > q0) {
            const int lim = iq - 32 * t - 4 * h;
#pragma unroll
            for (int i = 0; i < 16; ++i) if ((i & 3) + 8 * (i >> 2) > lim) st[i] = 0.f;
        }
        bf16x8 pf[2];
        pf[0] = pack8(st, 0); pf[1] = pack8(st, 8);
        s16x4 vl0[4], vh0[4], vl1[4], vh1[4];
        __builtin_amdgcn_sched_barrier(0);
        RV_LOAD(vl0, vh0, 0); __builtin_amdgcn_sched_barrier(0);
        RV_LOAD(vl1, vh1, 1); __builtin_amdgcn_sched_barrier(0); RV_MMA(vl0, vh0, 0); __builtin_amdgcn_sched_barrier(0);
        RV_LOAD(vl0, vh0, 2); __builtin_amdgcn_sched_barrier(0); RV_MMA(vl1, vh1, 1); __builtin_amdgcn_sched_barrier(0);
        RV_LOAD(vl1, vh1, 3); __builtin_amdgcn_sched_barrier(0); RV_MMA(vl0, vh0, 2); __builtin_amdgcn_sched_barrier(0);
        RV_MMA(vl1, vh1, 3);
    }
#undef RV_LOAD
#undef RV_MMA
}
DI void ret_unit(LAS unsigned char* lds, bf16_t* P, int b, int head, int qb, const int wid) {
    const int lane = olane(), r = lane & 31, h = lane >> 5;
    const int hh = wid >> 2, qg = wid & 3, q0 = 128 * qb + 32 * qg, iq = q0 + r;
    bf16_t* rowb = P + (size_t)b * SEQ * INW;
    bf16x8 qf[8];
    { const bf16_t* qp = rowb + (size_t)iq * INW + C_RQ + head * 256 + 128 * hh + 8 * h;
#pragma unroll
      for (int ks = 0; ks < 8; ++ks) qf[ks] = *(const bf16x8*)(qp + 16 * ks); }
    const int NT = 4 * (qb + 1);
    unsigned goff[6];
#pragma unroll
    for (int i = 0; i < 6; ++i) { const int L = wid * 6 + i;
        if (L < 16) { const int row = 2 * L + (lane >> 5), pos = lane & 31, ch = (pos & 16) + ((pos & 15) ^ fsw(row)); goff[i] = (unsigned)(row * INW + C_RK + head * 256 + ch * 8) * 2u; }
        else { const int row = L - 16, ch = (lane & 48) + ((lane & 15) ^ fsw(row)); goff[i] = (unsigned)(row * INW + C_RV + head * 512 + ch * 8) * 2u; } }
    const char* gb = (const char*)rowb;
    const float lg = __builtin_amdgcn_logf(1.f - __builtin_amdgcn_exp2f(-5.f - (float)head));
    const int fr_ = fsw(r);
    const int i16 = lane & 15, q4 = i16 >> 2, p4 = i16 & 3, gg = (lane >> 4) & 1;
    int vlow[2], ebx[4];
#pragma unroll
    for (int jh = 0; jh < 2; ++jh) vlow[jh] = 1024 * (8 * jh + 4 * h + q4) + 16 * ((2 * gg + (p4 >> 1)) ^ (2 * jh + h)) + 8 * (p4 & 1) + 512 * hh;
#pragma unroll
    for (int e3 = 0; e3 < 4; ++e3) ebx[e3] = 64 * (e3 ^ q4);
    const unsigned V0a = vlow[0] + 64 * q4, V0b = vlow[1] + 64 * q4;
    const unsigned K0 = 512 * r + 256 * hh + 16 * (h ^ fr_);
    LAS float* XS = (LAS float*)(lds + 98304 + wid * 4096) + lane;
    LAS const float* XP = (LAS const float*)(lds + 98304 + (wid ^ 4) * 4096) + lane;
    f32x16 o[8];
#pragma unroll
    for (int eb = 0; eb < 8; ++eb) o[eb] = zero16();
#define RET_DMA(t, bi) do { const char* src_ = gb + (size_t)(t) * 32 * INW * 2; _Pragma("unroll") for (int i_ = 0; i_ < 6; ++i_) dma16(src_ + goff[i_], lds + (bi) * 49152 + (wid * 6 + i_) * 1024); } while (0)
    RET_DMA(0, 0);
    for (int t = 0; t < NT; ++t) {
        WAITV0(); __syncthreads();
        if (t + 1 < NT) RET_DMA(t + 1, (t + 1) & 1);
        ret_tile<true>(o, qf, lds, t & 1, K0, V0a, V0b, XS, XP, t, iq, h, q0, lg);
    }
#undef RET_DMA
    float s1 = 0.f, s2 = 0.f;
#pragma unroll
    for (int eb = 0; eb < 8; ++eb)
#pragma unroll
        for (int i = 0; i < 16; ++i) { const float v = o[eb][i]; s1 += v; s2 += v * v; }
    s1 = xhalf_sum(s1); s2 = xhalf_sum(s2);
    __syncthreads();
    LAS float* ST = (LAS float*)lds;
    const int lane2 = olane(), r2 = lane2 & 31, h2 = lane2 >> 5, iq2 = q0 + r2;
    if (h2 == 0) { ST[(wid * 32 + r2) * 2] = s1; ST[(wid * 32 + r2) * 2 + 1] = s2; }
    __syncthreads();
    { const float t1 = s1 + ST[((wid ^ 4) * 32 + r2) * 2], t2 = s2 + ST[((wid ^ 4) * 32 + r2) * 2 + 1];
      const float mean = t1 * (1.f / 512.f); const float var = fmaxf(t2 * (1.f / 512.f) - mean * mean, 0.f);
      const float rstd = __builtin_amdgcn_rsqf(var + EPS);
      bf16_t* op = rowb + (size_t)iq2 * INW + C_RG + head * 512 + 256 * hh + 4 * h2;
#pragma unroll
      for (int eb = 0; eb < 8; ++eb)
#pragma unroll
          for (int g4 = 0; g4 < 4; ++g4) { bf16_t* pp = op + 32 * eb + 8 * g4; const u32x2 gq = *(const u32x2*)pp;
              u32x2 v; v.x = cvt_pk_bf16((o[eb][4 * g4 + 0] - mean) * rstd * bf_lo(gq.x), (o[eb][4 * g4 + 1] - mean) * rstd * bf_hi(gq.x));
              v.y = cvt_pk_bf16((o[eb][4 * g4 + 2] - mean) * rstd * bf_lo(gq.y), (o[eb][4 * g4 + 3] - mean) * rstd * bf_hi(gq.y));
              *(u32x2*)pp = v; } }
    __syncthreads();
}
}

DI void tr_item(const float* W, int K, int N, bf16_t* WT, int mode, LAS float* scr, int item, int lane) {
    const int nblk = N / 32, kb = item / nblk, nb = item % nblk, k0 = 64 * kb, n0 = 32 * nb;
    int rowbase = n0;
    if (mode) { const int which = n0 / FF, j = n0 - which * FF; rowbase = 256 * (j / 128) + 128 * which + (j % 128); }
#pragma unroll 8
    for (int i = 0; i < 32; ++i) { const int kk = 2 * i + (lane >> 5); scr[kk * 33 + (lane & 31)] = W[(size_t)(k0 + kk) * N + n0 + (lane & 31)]; }
    asm volatile("s_waitcnt lgkmcnt(0)" ::: "memory");
    const int c = lane & 7;
#pragma unroll
    for (int j = 0; j < 4; ++j) { const int n = (lane >> 3) + 8 * j; const LAS float* s = scr + (8 * c) * 33 + n;
        u32x4 o; o.x = cvt_pk_bf16(s[0 * 33], s[1 * 33]); o.y = cvt_pk_bf16(s[2 * 33], s[3 * 33]); o.z = cvt_pk_bf16(s[4 * 33], s[5 * 33]); o.w = cvt_pk_bf16(s[6 * 33], s[7 * 33]);
        *(u32x4*)(WT + (size_t)(rowbase + n) * K + k0 + 8 * c) = o; }
    asm volatile("s_waitcnt lgkmcnt(0)" ::: "memory");
}
DI void modulate_rows(const float* X, const float* g, const float* modsub, bf16_t* H, int ngw, const int wid) {
    const int lane = olane(), gw = opqi(blockIdx.x * 8 + wid);
    for (int m = gw; m < M; m += ngw) {
        const float* shift = modsub + (size_t)(m >> 11) * NMOD; const float* scale = shift + D;
        const f32x4* xr = (const f32x4*)(X + (size_t)m * D) + lane;
        f32x4 v[4]; float ss = 0.f;
#pragma unroll
        for (int j = 0; j < 4; ++j) { v[j] = xr[64 * j]; ss += (v[j].x * v[j].x + v[j].y * v[j].y) + (v[j].z * v[j].z + v[j].w * v[j].w); }
        const float rstd = __builtin_amdgcn_rsqf(wave_sum(ss) * (1.f / D) + EPS);
#pragma unroll
        for (int j = 0; j < 4; ++j) { const int k = 4 * (lane + 64 * j);
            const f32x4 gv = *(const f32x4*)(g + k), sc = *(const f32x4*)(scale + k), sh = *(const f32x4*)(shift + k);
            const f32x4 y = (v[j] * rstd * gv) * (sc + 1.f) + sh;
            u32x2 w; w.x = cvt_pk_bf16(y.x, y.y); w.y = cvt_pk_bf16(y.z, y.w);
            *(u32x2*)(H + (size_t)m * D + k) = w; }
    }
}

#define XB_TMO      128
#define XB_XCNT(j)  (256  + 64 * (j))
#define XB_XSUB(j)  (1280 + 64 * (j))
#define XB_XGEN(j)  (2304 + 64 * (j))
#define XB_TOP      3328
#define XB_TOPGEN   3392
#define XCD_BAR_WORDS 3456
#define XB_SPIN_CAP (1u << 18)
DI unsigned xb_ld(unsigned* p)              { return __hip_atomic_load(p, __ATOMIC_RELAXED, __HIP_MEMORY_SCOPE_AGENT); }
DI unsigned xb_add(unsigned* p, unsigned v) { return __hip_atomic_fetch_add(p, v, __ATOMIC_RELAXED, __HIP_MEMORY_SCOPE_AGENT); }
DI unsigned xb_xcc_id() { return (unsigned)__builtin_amdgcn_s_getreg((3 << 11) | 20) & 0xFu; }
#define XB_SPIN(cond, bar) do { unsigned _sp = 0; while (cond) { __builtin_amdgcn_s_sleep(1); \
    if ((++_sp & 255u) == 0u) { if (xb_ld(&(bar)[XB_TMO])) break; if (_sp > XB_SPIN_CAP) { atomicAdd(&(bar)[XB_TMO], 1u); break; } } } } while (0)
struct XcdBarrier { unsigned* bar; unsigned x; volatile LAS unsigned* st; };
DI XcdBarrier xcd_barrier_post(unsigned* bar, volatile LAS unsigned* st, bool lead) {
    XcdBarrier b; b.bar = bar; b.x = xb_xcc_id(); b.st = st;
    if (lead) (void)xb_add(&bar[XB_XCNT(b.x)], 1u);
    return b;
}
DI void xcd_barrier_complete(unsigned* bar, unsigned x, unsigned& nloc, unsigned& nx) {
    const unsigned G = gridDim.x * gridDim.y * gridDim.z;
    unsigned sum, cnt, mine, sp = 0u;
    for (;;) {
        sum = 0u; cnt = 0u; mine = 0u;
#pragma unroll
        for (unsigned j = 0; j < 16; ++j) { const unsigned c = xb_ld(&bar[XB_XCNT(j)]); sum += c; cnt += (c > 0u) ? 1u : 0u; mine = (j == x) ? c : mine; }
        if (sum == G) break;
        __builtin_amdgcn_s_sleep(1);
        if ((++sp & 255u) == 0u) { if (xb_ld(&bar[XB_TMO])) break; if (sp > XB_SPIN_CAP) { atomicAdd(&bar[XB_TMO], 1u); break; } }
    }
    nloc = mine > 0u ? mine : 1u; nx = cnt > 0u ? cnt : 1u;
}
DI void xcd_barrier(const XcdBarrier& b, bool lead) {
    asm volatile("s_waitcnt vmcnt(0)" ::: "memory");
    __syncthreads();
    if (lead) {
        unsigned* bar = b.bar;
        __builtin_amdgcn_s_waitcnt(0);
        unsigned nloc = b.st[0], nx = b.st[1];
        if (nloc == 0u) { xcd_barrier_complete(bar, b.x, nloc, nx); b.st[0] = nloc; b.st[1] = nx; }
        const unsigned old = xb_add(&bar[XB_XSUB(b.x)], 1u);
        const unsigned gen = old / nloc;
        if (old + 1u == (gen + 1u) * nloc) {
            __builtin_amdgcn_fence(__ATOMIC_RELEASE, "agent");
            asm volatile("s_waitcnt vmcnt(0)" ::: "memory");
            const unsigned og = xb_add(&bar[XB_TOP], 1u);
            const unsigned tg = og / nx;
            if (og + 1u == (tg + 1u) * nx) xb_add(&bar[XB_TOPGEN], 1u);
            else XB_SPIN(xb_ld(&bar[XB_TOPGEN]) == tg, bar);
            __builtin_amdgcn_fence(__ATOMIC_ACQUIRE, "agent");
            xb_add(&bar[XB_XGEN(b.x)], 1u);
            asm volatile("s_waitcnt vmcnt(0)" ::: "memory");
        } else {
            XB_SPIN(xb_ld(&bar[XB_XGEN(b.x)]) == gen, bar);
            __builtin_amdgcn_fence(__ATOMIC_ACQUIRE, "agent");
            asm volatile("s_waitcnt vmcnt(0)" ::: "memory");
        }
    }
    __syncthreads();
}

struct Args { const float* in[16]; float* out; unsigned char* ws; };

__global__ void __launch_bounds__(512, 2) mega(Args a) {
    extern __shared__ __attribute__((aligned(16))) unsigned char lds_raw[];
    LAS unsigned char* lds = (LAS unsigned char*)lds_raw;
    cg::grid_group grid = cg::this_grid();
    const int wid = __builtin_amdgcn_readfirstlane((int)threadIdx.x >> 6);
    const int G = gridDim.x, ngw = G * 8;
    unsigned char* ws = a.ws;
    const float* x_in = a.in[0];
    float* out = a.out;
#define mod ((float*)(opq(ws) + WS_MOD))
#define ctl ((unsigned*)(opq(ws) + WS_CTL))
#define W1I ((bf16_t*)(opq(ws) + WS_W1I))
#define W1O ((bf16_t*)(opq(ws) + WS_W1O))
#define WIN ((bf16_t*)(opq(ws) + WS_WIN))
#define WRO ((bf16_t*)(opq(ws) + WS_WRO))
#define WDO ((bf16_t*)(opq(ws) + WS_WDO))
#define WO ((bf16_t*)(opq(ws) + WS_WO))
#define H ((bf16_t*)(opq(ws) + WS_H))
#define BIG ((bf16_t*)(opq(ws) + WS_BIG))
    LAS unsigned* sflag = (LAS unsigned*)(lds + 131072);
    if (wid == 0) { const int l0 = olane(); if (l0 < 8) sflag[l0] = 0u; }
    __syncthreads();
    const XcdBarrier xbar = xcd_barrier_post((unsigned*)(ws + WS_BAR), (volatile LAS unsigned*)(sflag + 2), wid == 0 && olane() == 0);
#define GSYNC() xcd_barrier(xbar, wid == 0 && olane() == 0)

    for (int item = blockIdx.x; item < NMOD / 64; item += G) {
        const int lane = olane(), tid = wid * 64 + lane;
        LAS float* cs = (LAS float*)lds; LAS float* red = (LAS float*)(lds + 32768);
        for (int i = tid; i < NB * D; i += 512) cs[i] = siluf_(a.in[1][i]);
        __syncthreads();
        const int col = item * 64 + lane, k0 = wid * 128;
        float acc[8];
#pragma unroll
        for (int b = 0; b < 8; ++b) acc[b] = 0.f;
        const float* wp = a.in[2] + (size_t)k0 * NMOD + col;
#pragma unroll 8
        for (int k = 0; k < 128; ++k) { const float w = wp[(size_t)k * NMOD];
#pragma unroll
            for (int b = 0; b < 8; ++b) acc[b] += cs[b * D + k0 + k] * w; }
#pragma unroll
        for (int b = 0; b < 8; ++b) red[(wid * 8 + b) * 64 + lane] = acc[b];
        __syncthreads();
        { float s = 0.f;
#pragma unroll
          for (int w = 0; w < 8; ++w) s += red[(w * 8 + wid) * 64 + lane];
          mod[(size_t)wid * NMOD + col] = s + a.in[3][col]; }
        __syncthreads();
    }
    {
        const int lane = olane(), gw = opqi(blockIdx.x * 8 + wid);
        LAS float* scr = (LAS float*)(lds + wid * 16384);
        constexpr int I_FI = (D / 64) * (2 * FF / 32), I_FO = (FF / 64) * (D / 32), I_IN = (D / 64) * (INW / 32), I_RO = (2048 / 64) * (D / 32), I_DO = (D / 64) * (D / 32);
        constexpr int NIT = I_FI + I_FO + I_IN + I_RO + 2 * I_DO;
        for (int it = gw; it < NIT; it += ngw) {
            int r = it;
            if (r < I_FI) { tr_item(a.in[5], D, 2 * FF, W1I, 1, scr, r, lane); continue; } r -= I_FI;
            if (r < I_FO) { tr_item(a.in[6], FF, D, W1O, 0, scr, r, lane); continue; } r -= I_FO;
            if (r < I_IN) { tr_item(a.in[7], D, INW, WIN, 0, scr, r, lane); continue; } r -= I_IN;
            if (r < I_RO) { tr_item(a.in[8], 2048, D, WRO, 0, scr, r, lane); continue; } r -= I_RO;
            if (r < I_DO) { tr_item(a.in[11], D, D, WDO, 0, scr, r, lane); continue; } r -= I_DO;
            tr_item(a.in[12], D, D, WO, 0, scr, r, lane);
        }
    }
    grid.sync();

#pragma unroll 1
    for (int stage = 0; stage < 2; ++stage) {
        modulate_rows(stage == 0 ? x_in : out, a.in[4] + (stage == 0 ? 0 : 2 * D), mod + (stage == 0 ? 0 : 2 * 3 * D), H, ngw, wid);
        GSYNC();
        { pg8::Gemm g{H, W1I, M, 2 * FF, D, D, D}; pg8::StaticOrder S; S.init(M, 2 * FF, G, (int)blockIdx.x);
          pg8::EpiSwiglu E{BIG, FF};
          pg8::gemm_phase<pg8::EpiSwiglu, pg8::StaticOrder>(lds, g, S, E, wid); }
        GSYNC();
        { pg8::Gemm g{BIG, W1O, M, D, FF, FF, FF}; pg8::StaticOrder S; S.init(M, D, G, (int)blockIdx.x);
          pg8::EpiResid E{stage == 0 ? x_in : out, out, mod + (stage == 0 ? 0 : 2 * 3 * D) + 2 * D, 0.5f, 0};
          pg8::gemm_phase<pg8::EpiResid, pg8::StaticOrder>(lds, g, S, E, wid); }
        GSYNC();
        if (stage == 1) break;

        modulate_rows(out, a.in[4] + D, mod + 3 * D, H, ngw, wid);
        {
            const int lane = olane(), gw = opqi(blockIdx.x * 8 + wid);
            LAS float* scr = (LAS float*)(lds + wid * 16384);
            constexpr int I_FI = (D / 64) * (2 * FF / 32), I_FO = (FF / 64) * (D / 32);
            for (int it = gw; it < I_FI + I_FO; it += ngw) {
                if (it < I_FI) tr_item(a.in[13], D, 2 * FF, W1I, 1, scr, it, lane);
                else tr_item(a.in[14], FF, D, W1O, 0, scr, it - I_FI, lane);
            }
        }
        GSYNC();
        { const int lane = olane(); const float* lp = a.in[9]; const float s01 = wave_sum(lp[lane] * lp[64 + lane]), s23 = wave_sum(lp[128 + lane] * lp[192 + lane]);
          if (wid == 0 && lane == 0) ((LAS float*)sflag)[1] = __expf(s01) - __expf(s23) + 0.2f; }
#pragma unroll 1
        for (int grp = 0; grp < NB / GB; ++grp) {
            { pg8::Gemm g{H + (size_t)grp * MG * D, WIN, MG, INW, D, D, D}; pg8::StaticOrder S; S.init(MG, INW, G, (int)blockIdx.x);
              pg8::EpiProj E{BIG};
              pg8::gemm_phase<pg8::EpiProj, pg8::StaticOrder>(lds, g, S, E, wid); }
            GSYNC();
            for (int kx = 0; kx < 8; ++kx) {
                const int xq = (int)((xbar.x + (unsigned)kx) & 7u);
                for (;;) {
                    if (wid == 0 && olane() == 0) sflag[0] = atomicAdd(ctl + 64 * (grp * 8 + xq), 1u);
                    __syncthreads();
                    const int u = (int)sflag[0];
                    __syncthreads();
                    if (u >= 96) break;
                    int rem = u, typ = 0, qb = 0, which = 0;
                    for (int k = 32; k >= 1; --k) {
                        if (!(k & 1)) { if (rem < 2) { typ = 0; qb = (k >> 1) - 1; which = rem; break; } rem -= 2; }
                        if (k <= 16) { if (rem < 4) { typ = 1; qb = k - 1; which = rem; break; } rem -= 4; }
                    }
                    const int bh = xq + 8 * which;
                    if (typ == 0) att::ret_unit(lds, BIG, bh >> 2, bh & 3, qb, wid);
                    else att::diff_unit(lds, BIG, bh >> 3, bh & 7, qb, (const LAS float*)sflag + 1, a.in[10], wid);
                }
            }
            GSYNC();
            { pg8::StaticOrder S; S.init(MG, D, G, (int)blockIdx.x);
              { pg8::Gemm g{BIG + C_RG, WRO, MG, D, 2048, INW, 2048}; pg8::EpiY E{BIG, C_GT, 0}; pg8::gemm_phase<pg8::EpiY, pg8::StaticOrder>(lds, g, S, E, wid); }
              { pg8::Gemm g{BIG + C_DQ, WDO, MG, D, D, INW, D}; pg8::EpiY E{BIG, C_GT + D, 1}; pg8::gemm_phase<pg8::EpiY, pg8::StaticOrder>(lds, g, S, E, wid); } }
            GSYNC();
            { pg8::Gemm g{BIG, WO, MG, D, D, INW, D}; pg8::StaticOrder S; S.init(MG, D, G, (int)blockIdx.x);
              float* o2 = out + (size_t)grp * MG * D;
              pg8::EpiResid E{o2, o2, mod + 3 * D + 2 * D, 1.0f, grp * GB};
              pg8::gemm_phase<pg8::EpiResid, pg8::StaticOrder>(lds, g, S, E, wid); }
            GSYNC();
        }
    }
    const int lane = olane(), gw = opqi(blockIdx.x * 8 + wid);
    for (int m = gw; m < M; m += ngw) {
        f32x4* xr = (f32x4*)(out + (size_t)m * D) + lane;
        f32x4 v[4]; float ss = 0.f;
#pragma unroll
        for (int j = 0; j < 4; ++j) { v[j] = xr[64 * j]; ss += (v[j].x * v[j].x + v[j].y * v[j].y) + (v[j].z * v[j].z + v[j].w * v[j].w); }
        const float rstd = __builtin_amdgcn_rsqf(wave_sum(ss) * (1.f / D) + EPS);
#pragma unroll
        for (int j = 0; j < 4; ++j) { const f32x4 gv = *(const f32x4*)(a.in[15] + 4 * (lane + 64 * j)); xr[64 * j] = v[j] * rstd * gv; }
    }
}

extern "C" void kernel_launch(void* const* d_in, const int* in_sizes, int n_in, void* d_out, int out_size, void* d_ws, size_t ws_size, hipStream_t stream) {
    static int grid = 0;
    if (grid == 0) {
        if (n_in != 16 || out_size != M * D || ws_size < WS_END) { fprintf(stderr, "kernel_launch: unexpected problem (n_in %d out %d ws %zu)\n", n_in, out_size, ws_size); grid = -1; return; }
        int dev = 0, cus = 0, per_cu = 0;
        hipGetDevice(&dev); hipDeviceGetAttribute(&cus, hipDeviceAttributeMultiprocessorCount, dev);
        hipFuncSetAttribute((const void*)mega, hipFuncAttributeMaxDynamicSharedMemorySize, LDS_BYTES);
        hipOccupancyMaxActiveBlocksPerMultiprocessor(&per_cu, (const void*)mega, 512, LDS_BYTES);
        if (per_cu < 1) { fprintf(stderr, "kernel_launch: occupancy query says %d blocks per CU\n", per_cu); per_cu = 1; }
        grid = cus * 1;
    }
    if (grid < 0) return;
    hipMemsetAsync((char*)d_ws + WS_CTL, 0, CTL_ZERO, stream);
    Args a{};
    for (int i = 0; i < 16; ++i) a.in[i] = (const float*)d_in[i];
    a.out = (float*)d_out; a.ws = (unsigned char*)d_ws;
    void* args[] = {&a};
    hipError_t e = hipLaunchCooperativeKernel((const void*)mega, dim3(grid), dim3(512), args, LDS_BYTES, stream);
    if (e != hipSuccess) fprintf(stderr, "cooperative launch failed: %s (grid %d)\n", hipGetErrorString(e), grid);
}
```

```cpp
#include <hip/hip_runtime.h>
#include <hip/hip_cooperative_groups.h>
#include <cstdio>
#include <cstdint>
namespace cg = cooperative_groups;

#define LAS __attribute__((address_space(3)))
#define DI __device__ __forceinline__
typedef unsigned short bf16_t;
typedef short bf16x8 __attribute__((ext_vector_type(8)));
typedef float f32x4 __attribute__((ext_vector_type(4)));
typedef float f32x16 __attribute__((ext_vector_type(16)));
typedef unsigned u32x4 __attribute__((ext_vector_type(4)));
typedef unsigned u32x2 __attribute__((ext_vector_type(2)));
typedef short s16x4 __attribute__((ext_vector_type(4)));

constexpr int D = 1024, SEQ = 2048, NB = 8, M = NB * SEQ, FF = 2816, INW = 11264, NMOD = 9216;
constexpr int GB = 4, MG = GB * SEQ;
constexpr int C_RQ = 0, C_RK = 1024, C_RV = 2048, C_RG = 4096, C_DQ = 6144, C_DK = 7168, C_DV = 8192, C_GT = 9216;
constexpr float EPS = 1e-6f;
constexpr size_t MiB = 1u << 20;
constexpr size_t WS_CTL = 0, WS_BAR = 16384, CTL_ZERO = 65536, WS_MOD = 65536, WS_W1I = 1 * MiB, WS_W1O = 12 * MiB, WS_WIN = 18 * MiB, WS_WRO = 40 * MiB, WS_WDO = 44 * MiB, WS_WO = 46 * MiB,
                 WS_H = 48 * MiB, WS_BIG = 80 * MiB, WS_END = 256 * MiB;
constexpr int LDS_BYTES = 131072 + 256;

typedef float f32x2_t __attribute__((ext_vector_type(2))); typedef __bf16 bf16x2_t __attribute__((ext_vector_type(2)));
DI unsigned cvt_pk_bf16(float lo, float hi) { f32x2_t v = {lo, hi}; bf16x2_t b = __builtin_convertvector(v, bf16x2_t); return __builtin_bit_cast(unsigned, b); }
DI float bf_lo(unsigned w) { return __uint_as_float(w << 16); }
DI float bf_hi(unsigned w) { return __uint_as_float(w & 0xffff0000u); }
DI float sigmoidf_(float x) { return __builtin_amdgcn_rcpf(1.f + __expf(-x)); }
DI float siluf_(float x) { return x * sigmoidf_(x); }
DI unsigned char* opq(unsigned char* p) { asm volatile("" : "+s"(p)); return p; }
DI unsigned opqv(unsigned v) { asm volatile("" : "+v"(v)); return v; }
DI f32x16 zero16() { float z = 0.f; asm volatile("" : "+v"(z)); f32x16 r; _Pragma("unroll") for (int i = 0; i < 16; ++i) r[i] = z; return r; }
DI int opqi(int v) { asm volatile("" : "+s"(v)); return v; }
DI int olane() { int l; asm volatile("v_mbcnt_lo_u32_b32 %0, -1, 0\n\tv_mbcnt_hi_u32_b32 %0, -1, %0" : "=v"(l)); return l; }
DI float wave_sum(float v) {
    const int l = olane();
#pragma unroll
    for (int o = 1; o < 64; o <<= 1) v += __uint_as_float(__builtin_amdgcn_ds_bpermute((l ^ o) << 2, __float_as_uint(v)));
    return v;
}
DI float xhalf_sum(float v) { auto rr = __builtin_amdgcn_permlane32_swap(__float_as_uint(v), __float_as_uint(v), false, false); return __uint_as_float(rr[0]) + __uint_as_float(rr[1]); }
DI float xhalf_max(float v) { auto rr = __builtin_amdgcn_permlane32_swap(__float_as_uint(v), __float_as_uint(v), false, false); return fmaxf(__uint_as_float(rr[0]), __uint_as_float(rr[1])); }

namespace pg8 {
constexpr int BM = 256, BK = 64, HALF = 128, HTB = HALF * BK * 2, STAGE_BYTES = 8 * HTB, NXCD = 8, WGM = 8;
__host__ __device__ __forceinline__ int lds_byte(int r, int c) { const int st = (r >> 4) * 2 + (c >> 5), rr = r & 15, cc = c & 31, ob = rr * 64 + cc * 2; return st * 1024 + (ob ^ (((ob >> 9) & 1) << 5)); }
__host__ __device__ __forceinline__ void stage_rc(int b, int& R, int& C) { const int st = b / 1024, sb = b % 1024, swz = sb ^ (((sb >> 9) & 1) << 5); R = (st >> 1) * 16 + swz / 64; C = (st & 1) * 32 + (swz % 64) / 2; }
__host__ __device__ __forceinline__ int perm32(int rho) { const int n = rho >> 4, i = rho & 15; return 8 * (i >> 2) + 4 * n + (i & 3); }

struct Unit { int pm, pn; };
struct Gemm { const bf16_t* A; const bf16_t* Bt; int M, N, K, lda, ldb; };

struct StaticOrder {
    int nM, nN, nwg, G, c;
    __host__ __device__ void init(int M_, int N_, int G_, int c_) { nM = M_ / BM; nN = N_ / BM; nwg = nM * nN; G = G_; c = c_; }
    __host__ __device__ bool next(int i, Unit& u) const {
        const long L = (long)i * G + c; if (L >= nwg) return false;
        int wgid = (int)L; { const int q = nwg / NXCD, r = nwg % NXCD, xcd = wgid % NXCD, off = wgid / NXCD; wgid = (xcd < r ? xcd * (q + 1) : r * (q + 1) + (xcd - r) * q) + off; }
        const int nig = WGM * nN, gid = wgid / nig, fm = gid * WGM, gsz = (nM - fm) < WGM ? (nM - fm) : WGM;
        u.pm = fm + ((wgid % nig) % gsz); u.pn = (wgid % nig) / gsz; return true;
    }
};


struct EpiSwiglu {
    static constexpr bool PERM = true;
    bf16_t* U; int ldc;
    DI void operator()(const f32x4 (&acc)[2][2][4][2], const Unit& u, int wr, int wc, int fr, int fq) const {
        const int row0 = u.pm * BM + wr * 64 + fr, col0 = u.pn * 128 + wc * 32 + 8 * fq;
#pragma unroll
        for (int ai = 0; ai < 2; ++ai)
#pragma unroll
            for (int m = 0; m < 4; ++m) {
                bf16_t* rowp = U + (size_t)(row0 + ai * HALF + m * 16) * ldc + col0;
                const f32x4 a0 = acc[ai][0][m][0], a1 = acc[ai][0][m][1], b0 = acc[ai][1][m][0], b1 = acc[ai][1][m][1];
                float v[8];
#pragma unroll
                for (int i = 0; i < 4; ++i) { v[i] = siluf_(a0[i]) * b0[i]; v[4 + i] = siluf_(a1[i]) * b1[i]; }
                u32x4 w; w.x = cvt_pk_bf16(v[0], v[1]); w.y = cvt_pk_bf16(v[2], v[3]); w.z = cvt_pk_bf16(v[4], v[5]); w.w = cvt_pk_bf16(v[6], v[7]);
                *(u32x4*)rowp = w;
            }
    }
};
struct EpiResid {
    static constexpr bool PERM = false;
    const float* base; float* out; const float* gate; float coef; int b0;
    DI void operator()(const f32x4 (&acc)[2][2][4][2], const Unit& u, int wr, int wc, int fr, int fq) const {
        const int row0 = u.pm * BM + wr * 64 + fr, col0 = u.pn * BM + wc * 32 + 4 * fq;
        const float* gp = gate + (size_t)(b0 + (u.pm >> 3)) * NMOD + col0;
        f32x4 gv[2][2];
#pragma unroll
        for (int bj = 0; bj < 2; ++bj)
#pragma unroll
            for (int n = 0; n < 2; ++n) gv[bj][n] = *(const f32x4*)(gp + bj * HALF + n * 16) * coef;
#pragma unroll
        for (int ai = 0; ai < 2; ++ai)
#pragma unroll
            for (int m = 0; m < 4; ++m) {
                const size_t off = (size_t)(row0 + ai * HALF + m * 16) * D + col0;
#pragma unroll
                for (int bj = 0; bj < 2; ++bj)
#pragma unroll
                    for (int n = 0; n < 2; ++n) { const f32x4 x = *(const f32x4*)(base + off + bj * HALF + n * 16); *(f32x4*)(out + off + bj * HALF + n * 16) = x + gv[bj][n] * acc[ai][bj][m][n]; }
            }
    }
};
struct EpiProj {
    static constexpr bool PERM = true;
    bf16_t* P;
    DI void operator()(const f32x4 (&acc)[2][2][4][2], const Unit& u, int wr, int wc, int fr, int fq) const {
        const int row0 = u.pm * BM + wr * 64 + fr, col0 = u.pn * BM + wc * 32 + 8 * fq;
        const int t = u.pn >> 2; const int act = (t == 1) ? 1 : ((t == 4 || t == 5) ? 2 : ((t >= 9) ? 3 : ((t == 6) ? 4 : 0)));
        const float lgh = __builtin_amdgcn_logf(1.f - __builtin_amdgcn_exp2f(-5.f - (float)(u.pn & 3)));
#pragma unroll
        for (int ai = 0; ai < 2; ++ai)
#pragma unroll
            for (int m = 0; m < 4; ++m) {
                bf16_t* rowp = P + (size_t)(row0 + ai * HALF + m * 16) * INW + col0;
#pragma unroll
                for (int bj = 0; bj < 2; ++bj) {
                    f32x4 v0 = acc[ai][bj][m][0], v1 = acc[ai][bj][m][1];
                    if (act == 1) { const float f = 0.0625f * __builtin_amdgcn_exp2f(lgh * (float)(31 - ((row0 + m * 16) & 31))); v0 = v0 * f; v1 = v1 * f; }
                    else if (act == 4) { v0 = v0 * 0.18033688011112042f; v1 = v1 * 0.18033688011112042f; }
                    else if (act == 2) {
#pragma unroll
                        for (int i = 0; i < 4; ++i) { v0[i] = siluf_(v0[i]); v1[i] = siluf_(v1[i]); } }
                    else if (act == 3) {
#pragma unroll
                        for (int i = 0; i < 4; ++i) { v0[i] = sigmoidf_(v0[i]); v1[i] = sigmoidf_(v1[i]); } }
                    u32x4 w; w.x = cvt_pk_bf16(v0[0], v0[1]); w.y = cvt_pk_bf16(v0[2], v0[3]); w.z = cvt_pk_bf16(v1[0], v1[1]); w.w = cvt_pk_bf16(v1[2], v1[3]);
                    *(u32x4*)(rowp + bj * HALF) = w;
                }
            }
    }
};
struct EpiY {
    static constexpr bool PERM = true;
    bf16_t* P; int gcol; int add;
    DI void operator()(const f32x4 (&acc)[2][2][4][2], const Unit& u, int wr, int wc, int fr, int fq) const {
        const int row0 = u.pm * BM + wr * 64 + fr, col0 = u.pn * BM + wc * 32 + 8 * fq;
#pragma unroll
        for (int ai = 0; ai < 2; ++ai)
#pragma unroll
            for (int m = 0; m < 4; ++m) {
                bf16_t* rowp = P + (size_t)(row0 + ai * HALF + m * 16) * INW + col0;
#pragma unroll
                for (int bj = 0; bj < 2; ++bj) {
                    const f32x4 v0 = acc[ai][bj][m][0], v1 = acc[ai][bj][m][1];
                    const u32x4 g = *(const u32x4*)(rowp + gcol + bj * HALF);
                    float o[8];
                    o[0] = bf_lo(g.x) * v0[0]; o[1] = bf_hi(g.x) * v0[1]; o[2] = bf_lo(g.y) * v0[2]; o[3] = bf_hi(g.y) * v0[3];
                    o[4] = bf_lo(g.z) * v1[0]; o[5] = bf_hi(g.z) * v1[1]; o[6] = bf_lo(g.w) * v1[2]; o[7] = bf_hi(g.w) * v1[3];
                    if (add) { const u32x4 y = *(const u32x4*)(rowp + bj * HALF);
                        o[0] += bf_lo(y.x); o[1] += bf_hi(y.x); o[2] += bf_lo(y.y); o[3] += bf_hi(y.y); o[4] += bf_lo(y.z); o[5] += bf_hi(y.z); o[6] += bf_lo(y.w); o[7] += bf_hi(y.w); }
                    u32x4 w; w.x = cvt_pk_bf16(o[0], o[1]); w.y = cvt_pk_bf16(o[2], o[3]); w.z = cvt_pk_bf16(o[4], o[5]); w.w = cvt_pk_bf16(o[6], o[7]);
                    *(u32x4*)(rowp + bj * HALF) = w;
                }
            }
    }
};

template <class Epi, class Sched>
DI void gemm_phase(LAS unsigned char* lds, const Gemm g, const Sched& S, const Epi& E, const int wid) {
    const int lane = olane(), tid = wid * 64 + lane, wr = wid >> 2, wc = wid & 3, fr = lane & 15, fq = lane >> 4;
    const int K = g.K, nt = K / BK;
    unsigned voffA[2], voffB[2];
#pragma unroll
    for (int i = 0; i < 2; ++i) { int R, C; stage_rc(tid * 16 + i * 8192, R, C); const int Rb = Epi::PERM ? ((R & ~31) + perm32(R & 31)) : R;
        voffA[i] = (unsigned)(R * g.lda + C) * 2u; voffB[i] = (unsigned)(Rb * g.ldb + C) * 2u; }
    const size_t kstep = (size_t)(BK * 2);
    const size_t hsA = (size_t)HALF * g.lda * 2, hsB = (size_t)HALF * g.ldb * 2;
    const size_t tsA = 2 * hsA, tsB = 2 * hsB;
    const unsigned ldsw = (unsigned)wid * 1024u;
    const int aoff = lds_byte(wr * 64 + fr, fq * 8), boff = lds_byte(wc * 32 + fr, fq * 8);
#define PG8_SA(b, h) (((b) * 2 + (h)) * HTB)
#define PG8_SB(b, h) ((4 + (b) * 2 + (h)) * HTB)
#define PG8_STAGE(bufoff, gbase, voff) do { _Pragma("unroll") for (int _i = 0; _i < 2; ++_i) \
        __builtin_amdgcn_global_load_lds((const unsigned*)((const char*)(gbase) + (voff)[_i]), (LAS unsigned*)(lds + (bufoff) + ldsw + _i * 8192), 16, 0, 0); } while (0)
#define PG8_LDA(dst, b, h) do { _Pragma("unroll") for (int m = 0; m < 4; ++m) _Pragma("unroll") for (int k = 0; k < 2; ++k) dst[m][k] = *(const LAS bf16x8*)(lds + PG8_SA(b, h) + aoff + m * 2048 + k * 1024); } while (0)
#define PG8_LDB(dst, b, h) do { _Pragma("unroll") for (int n = 0; n < 2; ++n) _Pragma("unroll") for (int k = 0; k < 2; ++k) dst[n][k] = *(const LAS bf16x8*)(lds + PG8_SB(b, h) + boff + n * 2048 + k * 1024); } while (0)
#define PG8_MMA(ai, bj, At, Bt) do { __builtin_amdgcn_s_setprio(1); _Pragma("unroll") for (int m = 0; m < 4; ++m) _Pragma("unroll") for (int n = 0; n < 2; ++n) _Pragma("unroll") for (int k = 0; k < 2; ++k) \
        acc[ai][bj][m][n] = __builtin_amdgcn_mfma_f32_16x16x32_bf16(Bt[n][k], At[m][k], acc[ai][bj][m][n], 0, 0, 0); __builtin_amdgcn_s_setprio(0); } while (0)
#define PG8_WAIT_V(n) asm volatile("s_waitcnt vmcnt(" #n ")" ::: "memory")
#define PG8_WAIT_L(n) asm volatile("s_waitcnt lgkmcnt(" #n ")" ::: "memory")
#define PG8_BAR __builtin_amdgcn_s_barrier()
#define PG8_SCHED __builtin_amdgcn_sched_barrier(0)
    Unit cur, nxt; int ui = 0;
    if (!S.next(0, cur)) return;
    f32x4 acc[2][2][4][2];
#pragma unroll
    for (int a = 0; a < 2; ++a)
#pragma unroll
        for (int b = 0; b < 2; ++b)
#pragma unroll
            for (int m = 0; m < 4; ++m)
#pragma unroll
                for (int n = 0; n < 2; ++n) acc[a][b][m][n] = (f32x4){0.f, 0.f, 0.f, 0.f};
    bf16x8 At[4][2], B0[2][2], B1[2][2];
    const char* cA = (const char*)g.A + (size_t)cur.pm * tsA; const char* cB = (const char*)g.Bt + (size_t)cur.pn * tsB;
    PG8_STAGE(PG8_SB(0, 0), cB, voffB); PG8_STAGE(PG8_SB(0, 1), cB + hsB, voffB); PG8_STAGE(PG8_SA(0, 0), cA, voffA); PG8_STAGE(PG8_SA(0, 1), cA + hsA, voffA);
    if (wr == 1) PG8_BAR;
    PG8_WAIT_V(2); PG8_BAR;
    PG8_STAGE(PG8_SB(1, 0), cB + kstep, voffB); PG8_STAGE(PG8_SA(1, 0), cA + kstep, voffA); PG8_STAGE(PG8_SB(1, 1), cB + hsB + kstep, voffB);
    PG8_WAIT_V(6); PG8_BAR;
    for (;;) {
        const bool has_next = S.next(ui + 1, nxt);
        const char* nA = has_next ? (const char*)g.A + (size_t)nxt.pm * tsA : cA; const char* nB = has_next ? (const char*)g.Bt + (size_t)nxt.pn * tsB : cB;
        for (int t = 0; t < nt; t += 2) {
            const bool last = (t == nt - 2);
            const char* a1 = cA + (size_t)(t + 1) * kstep;
            const char* a2 = last ? nA : cA + (size_t)(t + 2) * kstep; const char* b2 = last ? nB : cB + (size_t)(t + 2) * kstep;
            const char* a3 = a2 + kstep; const char* b3 = b2 + kstep;
            PG8_LDB(B0, 0, 0); PG8_LDB(B1, 0, 1); PG8_SCHED; PG8_LDA(At, 0, 0); PG8_STAGE(PG8_SA(1, 1), a1 + hsA, voffA);
            PG8_WAIT_V(8); PG8_WAIT_L(0); PG8_BAR; PG8_MMA(0, 0, At, B0); PG8_MMA(0, 1, At, B1); PG8_BAR; PG8_SCHED;
            PG8_LDA(At, 0, 1); PG8_STAGE(PG8_SB(0, 0), b2, voffB); PG8_STAGE(PG8_SB(0, 1), b2 + hsB, voffB); PG8_STAGE(PG8_SA(0, 0), a2, voffA);
            PG8_WAIT_V(8); PG8_WAIT_L(0); PG8_BAR; PG8_MMA(1, 0, At, B0); PG8_MMA(1, 1, At, B1); PG8_BAR; PG8_SCHED;
            PG8_LDB(B0, 1, 0); PG8_LDB(B1, 1, 1); PG8_SCHED; PG8_LDA(At, 1, 0); PG8_STAGE(PG8_SA(0, 1), a2 + hsA, voffA);
            PG8_WAIT_V(8); PG8_WAIT_L(0); PG8_BAR; PG8_MMA(0, 0, At, B0); PG8_MMA(0, 1, At, B1); PG8_BAR; PG8_SCHED;
            PG8_LDA(At, 1, 1); PG8_STAGE(PG8_SB(1, 0), b3, voffB); PG8_STAGE(PG8_SB(1, 1), b3 + hsB, voffB); PG8_STAGE(PG8_SA(1, 0), a3, voffA);
            PG8_WAIT_V(8); PG8_WAIT_L(0); PG8_BAR; PG8_MMA(1, 0, At, B0); PG8_MMA(1, 1, At, B1); PG8_BAR; PG8_SCHED;
        }
        if (wr == 0) PG8_BAR;
        E(acc, cur, wr, wc, fr, fq);
        if (!has_next) break;
#pragma unroll
        for (int a = 0; a < 2; ++a)
#pragma unroll
            for (int b = 0; b < 2; ++b)
#pragma unroll
                for (int m = 0; m < 4; ++m)
#pragma unroll
                    for (int n = 0; n < 2; ++n) acc[a][b][m][n] = (f32x4){0.f, 0.f, 0.f, 0.f};
        cur = nxt; cA = nA; cB = nB; ++ui;
        if (wr == 1) PG8_BAR;
    }
    PG8_WAIT_V(0);
    PG8_BAR;
#undef PG8_SA
#undef PG8_SB
#undef PG8_STAGE
#undef PG8_LDA
#undef PG8_LDB
#undef PG8_MMA
#undef PG8_WAIT_V
#undef PG8_WAIT_L
#undef PG8_BAR
#undef PG8_SCHED
}
}

namespace att {
typedef short v4i16_t __attribute__((ext_vector_type(4)));
DI int fsw(int row) { return ((row & 3) << 2) | ((row >> 2) & 3); }
DI s16x4 vtr(LAS const unsigned char* p) { return __builtin_bit_cast(s16x4, __builtin_amdgcn_ds_read_tr16_b64_v4i16((LAS v4i16_t*)p)); }
DI void dma16(const void* g, LAS unsigned char* l) { __builtin_amdgcn_global_load_lds((const unsigned*)g, (LAS unsigned*)l, 16, 0, 0); }
#define MFMA32(a, b, c) __builtin_amdgcn_mfma_f32_32x32x16_bf16((a), (b), (c), 0, 0, 0)
DI bf16x8 pack8(const f32x16& x, int s8) {
    u32x4 p; p.x = cvt_pk_bf16(x[s8 + 0], x[s8 + 1]); p.y = cvt_pk_bf16(x[s8 + 2], x[s8 + 3]); p.z = cvt_pk_bf16(x[s8 + 4], x[s8 + 5]); p.w = cvt_pk_bf16(x[s8 + 6], x[s8 + 7]);
    return __builtin_bit_cast(bf16x8, p);
}
#define WAITV0() asm volatile("s_waitcnt vmcnt(0)" ::: "memory")

template <bool DIAG>
DI void diff_tile(f32x16 (&o)[4], float& mrun, float& lrun, bool& first, const bf16x8 (&qf)[4], LAS unsigned char* lds, const int bufi, const unsigned K0, const unsigned V0a, const unsigned V0b,
                  const int t, const int iq, const int h, const int q0, const float c2, const float c2x5) {
#define DV_LOAD(L, Hh, g_) do { _Pragma("unroll") for (int e2 = 0; e2 < 2; ++e2) { L[e2] = vtr((LAS const unsigned char*)(size_t)(va0 ^ (64 * (2 * ((g_) & 1) + e2))) + 4096 * ((g_) >> 1)); Hh[e2] = vtr((LAS const unsigned char*)(size_t)(va1 ^ (64 * (2 * ((g_) & 1) + e2))) + 4096 * ((g_) >> 1)); } } while (0)
#define DV_MMA(L, Hh, g_) do { _Pragma("unroll") for (int e2 = 0; e2 < 2; ++e2) { const bf16x8 vf = __builtin_shufflevector(L[e2], Hh[e2], 0, 1, 2, 3, 4, 5, 6, 7); o[2 * ((g_) & 1) + e2] = MFMA32(vf, pf[(g_) >> 1], o[2 * ((g_) & 1) + e2]); } } while (0)
            const unsigned kbase = (unsigned)(size_t)lds + (bufi) * 32768;
            const unsigned ka = opqv(kbase + K0), va0 = opqv(kbase + 16384 + V0a), va1 = opqv(kbase + 16384 + V0b);
            const float base = (float)(64 * t + 4 * h - iq) * c2 - mrun;
            f32x16 st[2];
            { float bv = base;
#pragma unroll
              for (int kb = 0; kb < 2; ++kb)
#pragma unroll
                  for (int i = 0; i < 16; ++i) { st[kb][i] = bv; bv += ((i & 3) == 3) ? c2x5 : c2; } }
            { bf16x8 kf[8];
#pragma unroll
              for (int kb = 0; kb < 2; ++kb)
#pragma unroll
                  for (int ks = 0; ks < 4; ++ks) kf[kb * 4 + ks] = *(const LAS bf16x8*)((size_t)(ka ^ (32 * ks)) + kb * 8192);
              __builtin_amdgcn_sched_barrier(0);
#pragma unroll
              for (int ks = 0; ks < 4; ++ks)
#pragma unroll
                  for (int kb = 0; kb < 2; ++kb) st[kb] = MFMA32(kf[kb * 4 + ks], qf[ks], st[kb]); }
            s16x4 vl0[2], vh0[2], vl1[2], vh1[2];
            __builtin_amdgcn_sched_barrier(0);
            DV_LOAD(vl0, vh0, 0);
            __builtin_amdgcn_sched_barrier(0);
            if (DIAG && 64 * t + 63 > q0) {
                const int lim = iq - 64 * t - 4 * h;
#pragma unroll
                for (int kb = 0; kb < 2; ++kb)
#pragma unroll
                    for (int i = 0; i < 16; ++i) if (32 * kb + (i & 3) + 8 * (i >> 2) > lim) st[kb][i] = -INFINITY;
            }
            float mx = fmaxf(st[0][0], st[1][0]);
#pragma unroll
            for (int i = 1; i < 16; ++i) mx = fmaxf(mx, fmaxf(st[0][i], st[1][i]));
            mx = xhalf_max(mx);
            if (DIAG && first) {
                first = false; mrun = mx;
#pragma unroll
                for (int kb = 0; kb < 2; ++kb)
#pragma unroll
                    for (int i = 0; i < 16; ++i) st[kb][i] -= mx;
            } else if (__any(mx > 5.f)) {
                const float dl = fmaxf(mx, 0.f), alpha = __builtin_amdgcn_exp2f(-dl);
                mrun += dl; lrun *= alpha;
#pragma unroll
                for (int kb = 0; kb < 2; ++kb)
#pragma unroll
                    for (int i = 0; i < 16; ++i) st[kb][i] -= dl;
#pragma unroll
                for (int eb = 0; eb < 4; ++eb) o[eb] = o[eb] * alpha;
            }
            float ls = 0.f;
#pragma unroll
            for (int kb = 0; kb < 2; ++kb)
#pragma unroll
                for (int i = 0; i < 16; ++i) { const float p = __builtin_amdgcn_exp2f(st[kb][i]); st[kb][i] = p; ls += p; }
            lrun += ls;
            bf16x8 pf[4];
#pragma unroll
            for (int s = 0; s < 4; ++s) pf[s] = pack8(st[s >> 1], 8 * (s & 1));
            __builtin_amdgcn_sched_barrier(0);
            DV_LOAD(vl1, vh1, 1); __builtin_amdgcn_sched_barrier(0); DV_MMA(vl0, vh0, 0); __builtin_amdgcn_sched_barrier(0);
            DV_LOAD(vl0, vh0, 2); __builtin_amdgcn_sched_barrier(0); DV_MMA(vl1, vh1, 1); __builtin_amdgcn_sched_barrier(0);
            DV_LOAD(vl1, vh1, 3); __builtin_amdgcn_sched_barrier(0); DV_MMA(vl0, vh0, 2); __builtin_amdgcn_sched_barrier(0);
            DV_LOAD(vl0, vh0, 4); __builtin_amdgcn_sched_barrier(0); DV_MMA(vl1, vh1, 3); __builtin_amdgcn_sched_barrier(0);
            DV_LOAD(vl1, vh1, 5); __builtin_amdgcn_sched_barrier(0); DV_MMA(vl0, vh0, 4); __builtin_amdgcn_sched_barrier(0);
            DV_LOAD(vl0, vh0, 6); __builtin_amdgcn_sched_barrier(0); DV_MMA(vl1, vh1, 5); __builtin_amdgcn_sched_barrier(0);
            DV_LOAD(vl1, vh1, 7); __builtin_amdgcn_sched_barrier(0); DV_MMA(vl0, vh0, 6); __builtin_amdgcn_sched_barrier(0);
            DV_MMA(vl1, vh1, 7);
#undef DV_LOAD
#undef DV_MMA
}
DI void diff_unit(LAS unsigned char* lds, bf16_t* P, int b, int head, int qb, const LAS float* lamp, const float* subln, const int wid) {
    const int lane = olane(), r = lane & 31, h = lane >> 5;
    const int mp = wid >> 2, qg = wid & 3, q0 = 128 * qb + 32 * qg, iq = q0 + r;
    bf16_t* rowb = P + (size_t)b * SEQ * INW;
    bf16x8 qf[4];
    { const bf16_t* qp = rowb + (size_t)iq * INW + C_DQ + head * 128 + mp * 64 + 8 * h;
#pragma unroll
      for (int ks = 0; ks < 4; ++ks) qf[ks] = *(const bf16x8*)(qp + 16 * ks); }
    const int NT = 2 * (qb + 1);
    unsigned koff[2], voff[2];
#pragma unroll
    for (int i = 0; i < 2; ++i) { const int L = wid * 2 + i, row = 4 * L + (lane >> 4), p = lane & 15, ch = p ^ fsw(row);
        koff[i] = (unsigned)(row * INW + C_DK + head * 128 + ch * 8) * 2u; voff[i] = (unsigned)(row * INW + C_DV + head * 128 + ch * 8) * 2u; }
    const char* gb = (const char*)rowb;
    const float slope = __builtin_amdgcn_exp2f(-(float)(head + 1));
    const float c2 = slope * 1.4426950408889634f, c2x5 = 5.f * c2;
    const int fr_ = fsw(r);
    const unsigned K0 = 256 * r + 16 * ((8 * mp + h) ^ fr_);
    const int i16 = lane & 15, q4 = i16 >> 2, p4 = i16 & 3, gg = (lane >> 4) & 1;
    int vlow[2], ebx[4];
#pragma unroll
    for (int jh = 0; jh < 2; ++jh) vlow[jh] = 256 * (8 * jh + 4 * h + q4) + 16 * ((2 * gg + (p4 >> 1)) ^ (2 * jh + h)) + 8 * (p4 & 1);
#pragma unroll
    for (int eb = 0; eb < 4; ++eb) ebx[eb] = 64 * (eb ^ q4);
    const unsigned V0a = vlow[0] + 64 * q4, V0b = vlow[1] + 64 * q4;
    f32x16 o[4];
#pragma unroll
    for (int eb = 0; eb < 4; ++eb) o[eb] = zero16();
    float mrun = 0.f, lrun = 0.f; bool first = true;
#define DIFF_DMA(t, bi) do { const char* src_ = gb + (size_t)(t) * 64 * INW * 2; _Pragma("unroll") for (int i_ = 0; i_ < 2; ++i_) { \
        dma16(src_ + koff[i_], lds + (bi) * 32768 + (wid * 2 + i_) * 1024); dma16(src_ + voff[i_], lds + (bi) * 32768 + 16384 + (wid * 2 + i_) * 1024); } } while (0)
    WAITV0();
    DIFF_DMA(NT - 1, 0); DIFF_DMA(NT - 2, 1); if (NT > 2) DIFF_DMA(NT - 3, 2);
    for (int it = 0; it < 2; ++it) {
        const int t = NT - 1 - it;
        if (it + 2 < NT) asm volatile("s_waitcnt vmcnt(8)\n\ts_barrier" ::: "memory");
        else if (it + 1 < NT) asm volatile("s_waitcnt vmcnt(4)\n\ts_barrier" ::: "memory");
        else asm volatile("s_waitcnt vmcnt(0)\n\ts_barrier" ::: "memory");
        if (it + 3 < NT) DIFF_DMA(t - 3, (it + 3) & 3);
        if (64 * t <= q0 + 31) diff_tile<true>(o, mrun, lrun, first, qf, lds, it & 3, K0, V0a, V0b, t, iq, h, q0, c2, c2x5);
    }
    for (int it = 2; it < NT; ++it) {
        const int t = NT - 1 - it;
        if (it + 2 < NT) asm volatile("s_waitcnt vmcnt(8)\n\ts_barrier" ::: "memory");
        else if (it + 1 < NT) asm volatile("s_waitcnt vmcnt(4)\n\ts_barrier" ::: "memory");
        else asm volatile("s_waitcnt vmcnt(0)\n\ts_barrier" ::: "memory");
        if (it + 3 < NT) DIFF_DMA(t - 3, (it + 3) & 3);
        diff_tile<false>(o, mrun, lrun, first, qf, lds, it & 3, K0, V0a, V0b, t, iq, h, q0, c2, c2x5);
    }
#undef DIFF_DMA
    { const float lt = xhalf_sum(lrun), inv = 1.f / lt;
#pragma unroll
      for (int eb = 0; eb < 4; ++eb) o[eb] = o[eb] * inv; }
    __syncthreads();
    LAS float* X = (LAS float*)(lds + qg * 16384);
    const int lane3 = olane();
    if (mp == 1) {
#pragma unroll
        for (int eb = 0; eb < 4; ++eb)
#pragma unroll
            for (int i = 0; i < 16; ++i) X[(eb * 16 + i) * 64 + lane3] = o[eb][i];
    }
    __syncthreads();
    if (mp == 0) {
        const int lane2 = olane(), h2 = lane2 >> 5, iq2 = q0 + (lane2 & 31);
        const float lam = lamp[0];
        float ss = 0.f;
#pragma unroll
        for (int eb = 0; eb < 4; ++eb)
#pragma unroll
            for (int i = 0; i < 16; ++i) { const float d = o[eb][i] - lam * X[(eb * 16 + i) * 64 + lane2]; o[eb][i] = d; ss += d * d; }
        ss = xhalf_sum(ss);
        const float rs = __builtin_amdgcn_rsqf(ss * (1.f / 128.f) + EPS) * 0.8f;
        bf16_t* op = rowb + (size_t)iq2 * INW + C_DQ + head * 128 + 4 * h2;
#pragma unroll
        for (int eb = 0; eb < 4; ++eb)
#pragma unroll
            for (int g4 = 0; g4 < 4; ++g4) { const int e = 32 * eb + 8 * g4; const f32x4 w = *(const f32x4*)(subln + e + 4 * h2);
                u32x2 v; v.x = cvt_pk_bf16(o[eb][4 * g4 + 0] * rs * w[0], o[eb][4 * g4 + 1] * rs * w[1]); v.y = cvt_pk_bf16(o[eb][4 * g4 + 2] * rs * w[2], o[eb][4 * g4 + 3] * rs * w[3]);
                *(u32x2*)(op + e) = v; }
    }
    __syncthreads();
}

DI void ret_unit(LAS unsigned char* lds, bf16_t* P, int b, int head, int qb, const int wid) {
    const int lane = olane(), r = lane & 31, h = lane >> 5;
    const int hh = wid >> 2, qg = wid & 3, q0 = 128 * qb + 32 * qg, iq = q0 + r;
    bf16_t* rowb = P + (size_t)b * SEQ * INW;
    bf16x8 qf[8];
    { const bf16_t* qp = rowb + (size_t)iq * INW + C_RQ + head * 256 + 128 * hh + 8 * h;
#pragma unroll
      for (int ks = 0; ks < 8; ++ks) qf[ks] = *(const bf16x8*)(qp + 16 * ks); }
    const int NT = 4 * (qb + 1);
    unsigned goff[6];
#pragma unroll
    for (int i = 0; i < 6; ++i) { const int L = wid * 6 + i;
        if (L < 16) { const int row = 2 * L + (lane >> 5), pos = lane & 31, ch = (pos & 16) + ((pos & 15) ^ fsw(row)); goff[i] = (unsigned)(row * INW + C_RK + head * 256 + ch * 8) * 2u; }
        else { const int row = L - 16, ch = (lane & 48) + ((lane & 15) ^ fsw(row)); goff[i] = (unsigned)(row * INW + C_RV + head * 512 + ch * 8) * 2u; } }
    const char* gb = (const char*)rowb;
    const float lg = __builtin_amdgcn_logf(1.f - __builtin_amdgcn_exp2f(-5.f - (float)head));
    const int fr_ = fsw(r);
    const int i16 = lane & 15, q4 = i16 >> 2, p4 = i16 & 3, gg = (lane >> 4) & 1;
    const unsigned V0a = 1024 * (4 * h + q4) + 16 * ((2 * gg + (p4 >> 1)) ^ h) + 8 * (p4 & 1) + 512 * hh + 64 * q4;
    const unsigned V0b = 1024 * (8 + 4 * h + q4) + 16 * ((2 * gg + (p4 >> 1)) ^ (2 + h)) + 8 * (p4 & 1) + 512 * hh + 64 * q4;
    const unsigned K0 = 512 * r + 256 * hh + 16 * (h ^ fr_);
    const unsigned xs_w = (unsigned)(size_t)lds + 98304 + wid * 2048 + lane * 16, xs_r = (unsigned)(size_t)lds + 98304 + (wid ^ 4) * 2048 + lane * 16;
    f32x16 o[8];
#pragma unroll
    for (int eb = 0; eb < 8; ++eb) o[eb] = zero16();
#define RET_DMA_K(t, bi) do { const char* src_ = gb + (size_t)(t) * 32 * INW * 2; _Pragma("unroll") for (int i_ = 0; i_ < 6; ++i_) if (wid * 6 + i_ < 16) dma16(src_ + goff[i_], lds + (bi) * 16384 + (wid * 6 + i_) * 1024); } while (0)
#define RET_DMA_V(t, bi) do { const char* src_ = gb + (size_t)(t) * 32 * INW * 2; _Pragma("unroll") for (int i_ = 0; i_ < 6; ++i_) if (wid * 6 + i_ >= 16) dma16(src_ + goff[i_], lds + 32768 + (bi) * 32768 + (wid * 6 + i_ - 16) * 1024); } while (0)
#define RET_QK(dst, bi) do { const unsigned ka_ = opqv((unsigned)(size_t)lds + (bi) * 16384 + K0); bf16x8 kf_[8]; \
        _Pragma("unroll") for (int ks = 0; ks < 8; ++ks) kf_[ks] = *(const LAS bf16x8*)(size_t)(ka_ ^ (32 * ks)); \
        _Pragma("unroll") for (int ks = 0; ks < 8; ++ks) dst = MFMA32(kf_[ks], qf[ks], dst); } while (0)
#define RET_XW(src, bi) do { u32x4 w0_, w1_; w0_.x = cvt_pk_bf16(src[0], src[1]); w0_.y = cvt_pk_bf16(src[2], src[3]); w0_.z = cvt_pk_bf16(src[4], src[5]); w0_.w = cvt_pk_bf16(src[6], src[7]); \
        w1_.x = cvt_pk_bf16(src[8], src[9]); w1_.y = cvt_pk_bf16(src[10], src[11]); w1_.z = cvt_pk_bf16(src[12], src[13]); w1_.w = cvt_pk_bf16(src[14], src[15]); \
        *(LAS u32x4*)(size_t)(xs_w + (bi) * 16384) = w0_; *(LAS u32x4*)(size_t)(xs_w + (bi) * 16384 + 1024) = w1_; } while (0)
    WAITV0();
    RET_DMA_K(0, 0); RET_DMA_V(0, 0); RET_DMA_K(1, 1);
    asm volatile("s_waitcnt vmcnt(0) lgkmcnt(0)\n\ts_barrier" ::: "memory");
    f32x16 sown = zero16();
    RET_QK(sown, 0);
    RET_XW(sown, 0);
    for (int t = 0; t < NT; ++t) {
        asm volatile("s_waitcnt vmcnt(0) lgkmcnt(0)\n\ts_barrier" ::: "memory");
        if (t + 1 < NT) RET_DMA_V(t + 1, (t + 1) & 1);
        if (t + 2 < NT) RET_DMA_K(t + 2, t & 1);
        const bool live_t = (32 * t <= q0 + 31), live_n = (t + 1 < NT) && (32 * (t + 1) <= q0 + 31);
        f32x16 snext = zero16();
        if (live_n) RET_QK(snext, (t + 1) & 1);
        if (live_t) {
            const unsigned va0 = opqv((unsigned)(size_t)lds + 32768 + (t & 1) * 32768 + V0a), va1 = opqv((unsigned)(size_t)lds + 32768 + (t & 1) * 32768 + V0b);
            const u32x4 x0 = *(const LAS u32x4*)(size_t)(xs_r + (t & 1) * 16384), x1 = *(const LAS u32x4*)(size_t)(xs_r + (t & 1) * 16384 + 1024);
            const float rowf = __builtin_amdgcn_exp2f(lg * (float)(iq - 32 * t - 31));
            f32x16 st;
            st[0] = sown[0] + bf_lo(x0.x); st[1] = sown[1] + bf_hi(x0.x); st[2] = sown[2] + bf_lo(x0.y); st[3] = sown[3] + bf_hi(x0.y);
            st[4] = sown[4] + bf_lo(x0.z); st[5] = sown[5] + bf_hi(x0.z); st[6] = sown[6] + bf_lo(x0.w); st[7] = sown[7] + bf_hi(x0.w);
            st[8] = sown[8] + bf_lo(x1.x); st[9] = sown[9] + bf_hi(x1.x); st[10] = sown[10] + bf_lo(x1.y); st[11] = sown[11] + bf_hi(x1.y);
            st[12] = sown[12] + bf_lo(x1.z); st[13] = sown[13] + bf_hi(x1.z); st[14] = sown[14] + bf_lo(x1.w); st[15] = sown[15] + bf_hi(x1.w);
#pragma unroll
            for (int i = 0; i < 16; ++i) st[i] *= rowf;
            if (32 * t + 31 > q0) {
                const int lim = iq - 32 * t - 4 * h;
#pragma unroll
                for (int i = 0; i < 16; ++i) if ((i & 3) + 8 * (i >> 2) > lim) st[i] = 0.f;
            }
            bf16x8 pf[2];
            pf[0] = pack8(st, 0); pf[1] = pack8(st, 8);
            s16x4 vl0[2], vh0[2], vl1[2], vh1[2];
#define RV_LOAD(L, Hh, g_) do { _Pragma("unroll") for (int e2 = 0; e2 < 2; ++e2) { const int eb_ = 2 * ((g_) & 3) + e2; L[e2] = vtr((LAS const unsigned char*)(size_t)(va0 ^ (64 * (eb_ & 3))) + 256 * (eb_ >> 2) + 16384 * ((g_) >> 2)); Hh[e2] = vtr((LAS const unsigned char*)(size_t)(va1 ^ (64 * (eb_ & 3))) + 256 * (eb_ >> 2) + 16384 * ((g_) >> 2)); } } while (0)
#define RV_MMA(L, Hh, g_) do { _Pragma("unroll") for (int e2 = 0; e2 < 2; ++e2) { const int eb_ = 2 * ((g_) & 3) + e2; const bf16x8 vf = __builtin_shufflevector(L[e2], Hh[e2], 0, 1, 2, 3, 4, 5, 6, 7); o[eb_] = MFMA32(vf, pf[(g_) >> 2], o[eb_]); } } while (0)
            RV_LOAD(vl0, vh0, 0);
            RV_LOAD(vl1, vh1, 1); RV_MMA(vl0, vh0, 0);
            RV_LOAD(vl0, vh0, 2); RV_MMA(vl1, vh1, 1);
            RV_LOAD(vl1, vh1, 3); RV_MMA(vl0, vh0, 2);
            RV_LOAD(vl0, vh0, 4); RV_MMA(vl1, vh1, 3);
            RV_LOAD(vl1, vh1, 5); RV_MMA(vl0, vh0, 4);
            RV_LOAD(vl0, vh0, 6); RV_MMA(vl1, vh1, 5);
            RV_LOAD(vl1, vh1, 7); RV_MMA(vl0, vh0, 6);
            RV_MMA(vl1, vh1, 7);
#undef RV_LOAD
#undef RV_MMA
        }
        if (live_n) RET_XW(snext, (t + 1) & 1);
        sown = snext;
    }
#undef RET_DMA_K
#undef RET_DMA_V
#undef RET_QK
#undef RET_XW
    float s1 = 0.f, s2 = 0.f;
#pragma unroll
    for (int eb = 0; eb < 8; ++eb)
#pragma unroll
        for (int i = 0; i < 16; ++i) { const float v = o[eb][i]; s1 += v; s2 += v * v; }
    s1 = xhalf_sum(s1); s2 = xhalf_sum(s2);
    __syncthreads();
    LAS float* ST = (LAS float*)lds;
    const int lane2 = olane(), r2 = lane2 & 31, h2 = lane2 >> 5, iq2 = q0 + r2;
    if (h2 == 0) { ST[(wid * 32 + r2) * 2] = s1; ST[(wid * 32 + r2) * 2 + 1] = s2; }
    __syncthreads();
    { const float t1 = s1 + ST[((wid ^ 4) * 32 + r2) * 2], t2 = s2 + ST[((wid ^ 4) * 32 + r2) * 2 + 1];
      const float mean = t1 * (1.f / 512.f); const float var = fmaxf(t2 * (1.f / 512.f) - mean * mean, 0.f);
      const float rstd = __builtin_amdgcn_rsqf(var + EPS);
      bf16_t* op = rowb + (size_t)iq2 * INW + C_RG + head * 512 + 256 * hh + 4 * h2;
#pragma unroll
      for (int eb = 0; eb < 8; ++eb)
#pragma unroll
          for (int g4 = 0; g4 < 4; ++g4) { bf16_t* pp = op + 32 * eb + 8 * g4; const u32x2 gq = *(const u32x2*)pp;
              u32x2 v; v.x = cvt_pk_bf16((o[eb][4 * g4 + 0] - mean) * rstd * bf_lo(gq.x), (o[eb][4 * g4 + 1] - mean) * rstd * bf_hi(gq.x));
              v.y = cvt_pk_bf16((o[eb][4 * g4 + 2] - mean) * rstd * bf_lo(gq.y), (o[eb][4 * g4 + 3] - mean) * rstd * bf_hi(gq.y));
              *(u32x2*)pp = v; } }
    __syncthreads();
}
}

DI void tr_item(const float* W, int K, int N, bf16_t* WT, int mode, LAS float* scr, int item, int lane) {
    const int nblk = N / 32, kb = item / nblk, nb = item % nblk, k0 = 64 * kb, n0 = 32 * nb;
    int rowbase = n0;
    if (mode) { const int which = n0 / FF, j = n0 - which * FF; rowbase = 256 * (j / 128) + 128 * which + (j % 128); }
#pragma unroll 8
    for (int i = 0; i < 32; ++i) { const int kk = 2 * i + (lane >> 5); scr[kk * 33 + (lane & 31)] = W[(size_t)(k0 + kk) * N + n0 + (lane & 31)]; }
    asm volatile("s_waitcnt lgkmcnt(0)" ::: "memory");
    const int c = lane & 7;
#pragma unroll
    for (int j = 0; j < 4; ++j) { const int n = (lane >> 3) + 8 * j; const LAS float* s = scr + (8 * c) * 33 + n;
        u32x4 o; o.x = cvt_pk_bf16(s[0 * 33], s[1 * 33]); o.y = cvt_pk_bf16(s[2 * 33], s[3 * 33]); o.z = cvt_pk_bf16(s[4 * 33], s[5 * 33]); o.w = cvt_pk_bf16(s[6 * 33], s[7 * 33]);
        *(u32x4*)(WT + (size_t)(rowbase + n) * K + k0 + 8 * c) = o; }
    asm volatile("s_waitcnt lgkmcnt(0)" ::: "memory");
}
DI void modulate_rows(const float* X, const float* g, const float* modsub, bf16_t* H, int ngw, const int wid) {
    const int lane = olane(), gw = opqi(blockIdx.x * 8 + wid);
    for (int m = gw; m < M; m += ngw) {
        const float* shift = modsub + (size_t)(m >> 11) * NMOD; const float* scale = shift + D;
        const f32x4* xr = (const f32x4*)(X + (size_t)m * D) + lane;
        f32x4 v[4]; float ss = 0.f;
#pragma unroll
        for (int j = 0; j < 4; ++j) { v[j] = xr[64 * j]; ss += (v[j].x * v[j].x + v[j].y * v[j].y) + (v[j].z * v[j].z + v[j].w * v[j].w); }
        const float rstd = __builtin_amdgcn_rsqf(wave_sum(ss) * (1.f / D) + EPS);
#pragma unroll
        for (int j = 0; j < 4; ++j) { const int k = 4 * (lane + 64 * j);
            const f32x4 gv = *(const f32x4*)(g + k), sc = *(const f32x4*)(scale + k), sh = *(const f32x4*)(shift + k);
            const f32x4 y = (v[j] * rstd * gv) * (sc + 1.f) + sh;
            u32x2 w; w.x = cvt_pk_bf16(y.x, y.y); w.y = cvt_pk_bf16(y.z, y.w);
            *(u32x2*)(H + (size_t)m * D + k) = w; }
    }
}

#define XB_TMO      128
#define XB_XCNT(j)  (256  + 64 * (j))
#define XB_XSUB(j)  (1280 + 64 * (j))
#define XB_XGEN(j)  (2304 + 64 * (j))
#define XB_TOP      3328
#define XB_TOPGEN   3392
#define XCD_BAR_WORDS 3456
#define XB_SPIN_CAP (1u << 18)
DI unsigned xb_ld(unsigned* p)              { return __hip_atomic_load(p, __ATOMIC_RELAXED, __HIP_MEMORY_SCOPE_AGENT); }
DI unsigned xb_add(unsigned* p, unsigned v) { return __hip_atomic_fetch_add(p, v, __ATOMIC_RELAXED, __HIP_MEMORY_SCOPE_AGENT); }
DI unsigned xb_xcc_id() { return (unsigned)__builtin_amdgcn_s_getreg((3 << 11) | 20) & 0xFu; }
#define XB_SPIN(cond, bar) do { unsigned _sp = 0; while (cond) { __builtin_amdgcn_s_sleep(1); \
    if ((++_sp & 255u) == 0u) { if (xb_ld(&(bar)[XB_TMO])) break; if (_sp > XB_SPIN_CAP) { atomicAdd(&(bar)[XB_TMO], 1u); break; } } } } while (0)
struct XcdBarrier { unsigned* bar; unsigned x; volatile LAS unsigned* st; };
DI XcdBarrier xcd_barrier_post(unsigned* bar, volatile LAS unsigned* st, bool lead) {
    XcdBarrier b; b.bar = bar; b.x = xb_xcc_id(); b.st = st;
    if (lead) (void)xb_add(&bar[XB_XCNT(b.x)], 1u);
    return b;
}
DI void xcd_barrier_complete(unsigned* bar, unsigned x, unsigned& nloc, unsigned& nx) {
    const unsigned G = gridDim.x * gridDim.y * gridDim.z;
    unsigned sum, cnt, mine, sp = 0u;
    for (;;) {
        sum = 0u; cnt = 0u; mine = 0u;
#pragma unroll
        for (unsigned j = 0; j < 16; ++j) { const unsigned c = xb_ld(&bar[XB_XCNT(j)]); sum += c; cnt += (c > 0u) ? 1u : 0u; mine = (j == x) ? c : mine; }
        if (sum == G) break;
        __builtin_amdgcn_s_sleep(1);
        if ((++sp & 255u) == 0u) { if (xb_ld(&bar[XB_TMO])) break; if (sp > XB_SPIN_CAP) { atomicAdd(&bar[XB_TMO], 1u); break; } }
    }
    nloc = mine > 0u ? mine : 1u; nx = cnt > 0u ? cnt : 1u;
}
DI void xcd_barrier(const XcdBarrier& b, bool lead) {
    asm volatile("s_waitcnt vmcnt(0)" ::: "memory");
    __syncthreads();
    if (lead) {
        unsigned* bar = b.bar;
        __builtin_amdgcn_s_waitcnt(0);
        unsigned nloc = b.st[0], nx = b.st[1];
        if (nloc == 0u) { xcd_barrier_complete(bar, b.x, nloc, nx); b.st[0] = nloc; b.st[1] = nx; }
        const unsigned old = xb_add(&bar[XB_XSUB(b.x)], 1u);
        const unsigned gen = old / nloc;
        if (old + 1u == (gen + 1u) * nloc) {
            __builtin_amdgcn_fence(__ATOMIC_RELEASE, "agent");
            asm volatile("s_waitcnt vmcnt(0)" ::: "memory");
            const unsigned og = xb_add(&bar[XB_TOP], 1u);
            const unsigned tg = og / nx;
            if (og + 1u == (tg + 1u) * nx) xb_add(&bar[XB_TOPGEN], 1u);
            else XB_SPIN(xb_ld(&bar[XB_TOPGEN]) == tg, bar);
            __builtin_amdgcn_fence(__ATOMIC_ACQUIRE, "agent");
            xb_add(&bar[XB_XGEN(b.x)], 1u);
            asm volatile("s_waitcnt vmcnt(0)" ::: "memory");
        } else {
            XB_SPIN(xb_ld(&bar[XB_XGEN(b.x)]) == gen, bar);
            __builtin_amdgcn_fence(__ATOMIC_ACQUIRE, "agent");
            asm volatile("s_waitcnt vmcnt(0)" ::: "memory");
        }
    }
    __syncthreads();
}

struct Args { const float* in[16]; float* out; unsigned char* ws; };

__global__ void __launch_bounds__(512, 2) mega(Args a) {
    extern __shared__ __attribute__((aligned(16))) unsigned char lds_raw[];
    LAS unsigned char* lds = (LAS unsigned char*)lds_raw;
    cg::grid_group grid = cg::this_grid();
    const int wid = __builtin_amdgcn_readfirstlane((int)threadIdx.x >> 6);
    const int G = gridDim.x, ngw = G * 8;
    unsigned char* ws = a.ws;
    const float* x_in = a.in[0];
    float* out = a.out;
#define mod ((float*)(opq(ws) + WS_MOD))
#define ctl ((unsigned*)(opq(ws) + WS_CTL))
#define W1I ((bf16_t*)(opq(ws) + WS_W1I))
#define W1O ((bf16_t*)(opq(ws) + WS_W1O))
#define WIN ((bf16_t*)(opq(ws) + WS_WIN))
#define WRO ((bf16_t*)(opq(ws) + WS_WRO))
#define WDO ((bf16_t*)(opq(ws) + WS_WDO))
#define WO ((bf16_t*)(opq(ws) + WS_WO))
#define H ((bf16_t*)(opq(ws) + WS_H))
#define BIG ((bf16_t*)(opq(ws) + WS_BIG))
    LAS unsigned* sflag = (LAS unsigned*)(lds + 131072);
    if (wid == 0) { const int l0 = olane(); if (l0 < 8) sflag[l0] = 0u; }
    __syncthreads();
    const XcdBarrier xbar = xcd_barrier_post((unsigned*)(ws + WS_BAR), (volatile LAS unsigned*)(sflag + 2), wid == 0 && olane() == 0);
#define GSYNC() xcd_barrier(xbar, wid == 0 && olane() == 0)

    for (int item = blockIdx.x; item < NMOD / 64; item += G) {
        const int lane = olane(), tid = wid * 64 + lane;
        LAS float* cs = (LAS float*)lds; LAS float* red = (LAS float*)(lds + 32768);
        for (int i = tid; i < NB * D; i += 512) cs[i] = siluf_(a.in[1][i]);
        __syncthreads();
        const int col = item * 64 + lane, k0 = wid * 128;
        float acc[8];
#pragma unroll
        for (int b = 0; b < 8; ++b) acc[b] = 0.f;
        const float* wp = a.in[2] + (size_t)k0 * NMOD + col;
#pragma unroll 8
        for (int k = 0; k < 128; ++k) { const float w = wp[(size_t)k * NMOD];
#pragma unroll
            for (int b = 0; b < 8; ++b) acc[b] += cs[b * D + k0 + k] * w; }
#pragma unroll
        for (int b = 0; b < 8; ++b) red[(wid * 8 + b) * 64 + lane] = acc[b];
        __syncthreads();
        { float s = 0.f;
#pragma unroll
          for (int w = 0; w < 8; ++w) s += red[(w * 8 + wid) * 64 + lane];
          mod[(size_t)wid * NMOD + col] = s + a.in[3][col]; }
        __syncthreads();
    }
    {
        const int lane = olane(), gw = opqi(blockIdx.x * 8 + wid);
        LAS float* scr = (LAS float*)(lds + wid * 16384);
        constexpr int I_FI = (D / 64) * (2 * FF / 32), I_FO = (FF / 64) * (D / 32), I_IN = (D / 64) * (INW / 32), I_RO = (2048 / 64) * (D / 32), I_DO = (D / 64) * (D / 32);
        constexpr int NIT = I_FI + I_FO + I_IN + I_RO + 2 * I_DO;
        for (int it = gw; it < NIT; it += ngw) {
            int r = it;
            if (r < I_FI) { tr_item(a.in[5], D, 2 * FF, W1I, 1, scr, r, lane); continue; } r -= I_FI;
            if (r < I_FO) { tr_item(a.in[6], FF, D, W1O, 0, scr, r, lane); continue; } r -= I_FO;
            if (r < I_IN) { tr_item(a.in[7], D, INW, WIN, 0, scr, r, lane); continue; } r -= I_IN;
            if (r < I_RO) { tr_item(a.in[8], 2048, D, WRO, 0, scr, r, lane); continue; } r -= I_RO;
            if (r < I_DO) { tr_item(a.in[11], D, D, WDO, 0, scr, r, lane); continue; } r -= I_DO;
            tr_item(a.in[12], D, D, WO, 0, scr, r, lane);
        }
    }
    grid.sync();

#pragma unroll 1
    for (int stage = 0; stage < 2; ++stage) {
        modulate_rows(stage == 0 ? x_in : out, a.in[4] + (stage == 0 ? 0 : 2 * D), mod + (stage == 0 ? 0 : 2 * 3 * D), H, ngw, wid);
        GSYNC();
        { pg8::Gemm g{H, W1I, M, 2 * FF, D, D, D}; pg8::StaticOrder S; S.init(M, 2 * FF, G, (int)blockIdx.x);
          pg8::EpiSwiglu E{BIG, FF};
          pg8::gemm_phase<pg8::EpiSwiglu, pg8::StaticOrder>(lds, g, S, E, wid); }
        GSYNC();
        { pg8::Gemm g{BIG, W1O, M, D, FF, FF, FF}; pg8::StaticOrder S; S.init(M, D, G, (int)blockIdx.x);
          pg8::EpiResid E{stage == 0 ? x_in : out, out, mod + (stage == 0 ? 0 : 2 * 3 * D) + 2 * D, 0.5f, 0};
          pg8::gemm_phase<pg8::EpiResid, pg8::StaticOrder>(lds, g, S, E, wid); }
        GSYNC();
        if (stage == 1) break;

        modulate_rows(out, a.in[4] + D, mod + 3 * D, H, ngw, wid);
        {
            const int lane = olane(), gw = opqi(blockIdx.x * 8 + wid);
            LAS float* scr = (LAS float*)(lds + wid * 16384);
            constexpr int I_FI = (D / 64) * (2 * FF / 32), I_FO = (FF / 64) * (D / 32);
            for (int it = gw; it < I_FI + I_FO; it += ngw) {
                if (it < I_FI) tr_item(a.in[13], D, 2 * FF, W1I, 1, scr, it, lane);
                else tr_item(a.in[14], FF, D, W1O, 0, scr, it - I_FI, lane);
            }
        }
        GSYNC();
        { const int lane = olane(); const float* lp = a.in[9]; const float s01 = wave_sum(lp[lane] * lp[64 + lane]), s23 = wave_sum(lp[128 + lane] * lp[192 + lane]);
          if (wid == 0 && lane == 0) ((LAS float*)sflag)[1] = __expf(s01) - __expf(s23) + 0.2f; }
#pragma unroll 1
        for (int grp = 0; grp < NB / GB; ++grp) {
            { pg8::Gemm g{H + (size_t)grp * MG * D, WIN, MG, INW, D, D, D}; pg8::StaticOrder S; S.init(MG, INW, G, (int)blockIdx.x);
              pg8::EpiProj E{BIG};
              pg8::gemm_phase<pg8::EpiProj, pg8::StaticOrder>(lds, g, S, E, wid); }
            GSYNC();
            for (int kx = 0; kx < 8; ++kx) {
                const int xq = (int)((xbar.x + (unsigned)kx) & 7u);
                for (;;) {
                    if (wid == 0 && olane() == 0) sflag[0] = atomicAdd(ctl + 64 * (grp * 8 + xq), 1u);
                    __syncthreads();
                    const int u = (int)sflag[0];
                    __syncthreads();
                    if (u >= 96) break;
                    int rem = u, typ = 0, qb = 0, which = 0;
                    for (int k = 32; k >= 1; --k) {
                        if (!(k & 1)) { if (rem < 2) { typ = 0; qb = (k >> 1) - 1; which = rem; break; } rem -= 2; }
                        if (k <= 16) { if (rem < 4) { typ = 1; qb = k - 1; which = rem; break; } rem -= 4; }
                    }
                    const int bh = xq + 8 * which;
                    if (typ == 0) att::ret_unit(lds, BIG, bh >> 2, bh & 3, qb, wid);
                    else att::diff_unit(lds, BIG, bh >> 3, bh & 7, qb, (const LAS float*)sflag + 1, a.in[10], wid);
                }
            }
            GSYNC();
            { pg8::StaticOrder S; S.init(MG, D, G, (int)blockIdx.x);
              { pg8::Gemm g{BIG + C_RG, WRO, MG, D, 2048, INW, 2048}; pg8::EpiY E{BIG, C_GT, 0}; pg8::gemm_phase<pg8::EpiY, pg8::StaticOrder>(lds, g, S, E, wid); }
              { pg8::Gemm g{BIG + C_DQ, WDO, MG, D, D, INW, D}; pg8::EpiY E{BIG, C_GT + D, 1}; pg8::gemm_phase<pg8::EpiY, pg8::StaticOrder>(lds, g, S, E, wid); } }
            GSYNC();
            { pg8::Gemm g{BIG, WO, MG, D, D, INW, D}; pg8::StaticOrder S; S.init(MG, D, G, (int)blockIdx.x);
              float* o2 = out + (size_t)grp * MG * D;
              pg8::EpiResid E{o2, o2, mod + 3 * D + 2 * D, 1.0f, grp * GB};
              pg8::gemm_phase<pg8::EpiResid, pg8::StaticOrder>(lds, g, S, E, wid); }
            GSYNC();
        }
    }
    const int lane = olane(), gw = opqi(blockIdx.x * 8 + wid);
    for (int m = gw; m < M; m += ngw) {
        f32x4* xr = (f32x4*)(out + (size_t)m * D) + lane;
        f32x4 v[4]; float ss = 0.f;
#pragma unroll
        for (int j = 0; j < 4; ++j) { v[j] = xr[64 * j]; ss += (v[j].x * v[j].x + v[j].y * v[j].y) + (v[j].z * v[j].z + v[j].w * v[j].w); }
        const float rstd = __builtin_amdgcn_rsqf(wave_sum(ss) * (1.f / D) + EPS);
#pragma unroll
        for (int j = 0; j < 4; ++j) { const f32x4 gv = *(const f32x4*)(a.in[15] + 4 * (lane + 64 * j)); xr[64 * j] = v[j] * rstd * gv; }
    }
}

extern "C" void kernel_launch(void* const* d_in, const int* in_sizes, int n_in, void* d_out, int out_size, void* d_ws, size_t ws_size, hipStream_t stream) {
    static int grid = 0;
    if (grid == 0) {
        if (n_in != 16 || out_size != M * D || ws_size < WS_END) { fprintf(stderr, "kernel_launch: unexpected problem (n_in %d out %d ws %zu)\n", n_in, out_size, ws_size); grid = -1; return; }
        int dev = 0, cus = 0, per_cu = 0;
        hipGetDevice(&dev); hipDeviceGetAttribute(&cus, hipDeviceAttributeMultiprocessorCount, dev);
        hipFuncSetAttribute((const void*)mega, hipFuncAttributeMaxDynamicSharedMemorySize, LDS_BYTES);
        hipOccupancyMaxActiveBlocksPerMultiprocessor(&per_cu, (const void*)mega, 512, LDS_BYTES);
        if (per_cu < 1) { fprintf(stderr, "kernel_launch: occupancy query says %d blocks per CU\n", per_cu); per_cu = 1; }
        grid = cus * 1;
    }
    if (grid < 0) return;
    hipMemsetAsync((char*)d_ws + WS_CTL, 0, CTL_ZERO, stream);
    Args a{};
    for (int i = 0; i < 16; ++i) a.in[i] = (const float*)d_in[i];
    a.out = (float*)d_out; a.ws = (unsigned char*)d_ws;
    void* args[] = {&a};
    hipError_t e = hipLaunchCooperativeKernel((const void*)mega, dim3(grid), dim3(512), args, LDS_BYTES, stream);
    if (e != hipSuccess) fprintf(stderr, "cooperative launch failed: %s (grid %d)\n", hipGetErrorString(e), grid);
}
```

```cpp
#include <hip/hip_runtime.h>
#include <hip/hip_cooperative_groups.h>
#include <cstdio>
#include <cstdint>
namespace cg = cooperative_groups;

#define LAS __attribute__((address_space(3)))
#define DI __device__ __forceinline__
typedef unsigned short bf16_t;
typedef short bf16x8 __attribute__((ext_vector_type(8)));
typedef float f32x4 __attribute__((ext_vector_type(4)));
typedef float f32x16 __attribute__((ext_vector_type(16)));
typedef unsigned u32x4 __attribute__((ext_vector_type(4)));
typedef unsigned u32x2 __attribute__((ext_vector_type(2)));
typedef short s16x4 __attribute__((ext_vector_type(4)));

constexpr int D = 1024, SEQ = 2048, NB = 8, M = NB * SEQ, FF = 2816, INW = 11264, NMOD = 9216;
constexpr int GB = 4, MG = GB * SEQ;
constexpr int C_RQ = 0, C_RK = 1024, C_RV = 2048, C_RG = 4096, C_DQ = 6144, C_DK = 7168, C_DV = 8192, C_GT = 9216;
constexpr float EPS = 1e-6f;
constexpr size_t MiB = 1u << 20;
constexpr size_t WS_CTL = 0, WS_BAR = 16384, CTL_ZERO = 65536, WS_MOD = 65536, WS_W1I = 1 * MiB, WS_W1O = 12 * MiB, WS_WIN = 18 * MiB, WS_WRO = 40 * MiB, WS_WDO = 44 * MiB, WS_WO = 46 * MiB,
                 WS_H = 48 * MiB, WS_BIG = 80 * MiB, WS_END = 256 * MiB;
constexpr int LDS_BYTES = 131072 + 256;

typedef float f32x2_t __attribute__((ext_vector_type(2))); typedef __bf16 bf16x2_t __attribute__((ext_vector_type(2)));
DI unsigned cvt_pk_bf16(float lo, float hi) { f32x2_t v = {lo, hi}; bf16x2_t b = __builtin_convertvector(v, bf16x2_t); return __builtin_bit_cast(unsigned, b); }
DI float bf_lo(unsigned w) { return __uint_as_float(w << 16); }
DI float bf_hi(unsigned w) { return __uint_as_float(w & 0xffff0000u); }
DI float sigmoidf_(float x) { return __builtin_amdgcn_rcpf(1.f + __expf(-x)); }
DI float siluf_(float x) { return x * sigmoidf_(x); }
DI unsigned char* opq(unsigned char* p) { asm volatile("" : "+s"(p)); return p; }
DI unsigned opqv(unsigned v) { asm volatile("" : "+v"(v)); return v; }
DI f32x16 zero16() { float z = 0.f; asm volatile("" : "+v"(z)); f32x16 r; _Pragma("unroll") for (int i = 0; i < 16; ++i) r[i] = z; return r; }
DI int opqi(int v) { asm volatile("" : "+s"(v)); return v; }
DI int olane() { int l; asm volatile("v_mbcnt_lo_u32_b32 %0, -1, 0\n\tv_mbcnt_hi_u32_b32 %0, -1, %0" : "=v"(l)); return l; }
DI float wave_sum(float v) {
    const int l = olane();
#pragma unroll
    for (int o = 1; o < 64; o <<= 1) v += __uint_as_float(__builtin_amdgcn_ds_bpermute((l ^ o) << 2, __float_as_uint(v)));
    return v;
}
DI float xhalf_sum(float v) { auto rr = __builtin_amdgcn_permlane32_swap(__float_as_uint(v), __float_as_uint(v), false, false); return __uint_as_float(rr[0]) + __uint_as_float(rr[1]); }
DI float xhalf_max(float v) { auto rr = __builtin_amdgcn_permlane32_swap(__float_as_uint(v), __float_as_uint(v), false, false); return fmaxf(__uint_as_float(rr[0]), __uint_as_float(rr[1])); }

namespace pg8 {
constexpr int BM = 256, BK = 64, HALF = 128, HTB = HALF * BK * 2, STAGE_BYTES = 8 * HTB, NXCD = 8, WGM = 8;
__host__ __device__ __forceinline__ int lds_byte(int r, int c) { const int st = (r >> 4) * 2 + (c >> 5), rr = r & 15, cc = c & 31, ob = rr * 64 + cc * 2; return st * 1024 + (ob ^ (((ob >> 9) & 1) << 5)); }
__host__ __device__ __forceinline__ void stage_rc(int b, int& R, int& C) { const int st = b / 1024, sb = b % 1024, swz = sb ^ (((sb >> 9) & 1) << 5); R = (st >> 1) * 16 + swz / 64; C = (st & 1) * 32 + (swz % 64) / 2; }
__host__ __device__ __forceinline__ int perm32(int rho) { const int n = rho >> 4, i = rho & 15; return 8 * (i >> 2) + 4 * n + (i & 3); }

struct Unit { int pm, pn; };
struct Gemm { const bf16_t* A; const bf16_t* Bt; int M, N, K, lda, ldb; };

struct StaticOrder {
    int nM, nN, nwg, G, c;
    __host__ __device__ void init(int M_, int N_, int G_, int c_) { nM = M_ / BM; nN = N_ / BM; nwg = nM * nN; G = G_; c = c_; }
    __host__ __device__ bool next(int i, Unit& u) const {
        const long L = (long)i * G + c; if (L >= nwg) return false;
        int wgid = (int)L; { const int q = nwg / NXCD, r = nwg % NXCD, xcd = wgid % NXCD, off = wgid / NXCD; wgid = (xcd < r ? xcd * (q + 1) : r * (q + 1) + (xcd - r) * q) + off; }
        const int nig = WGM * nN, gid = wgid / nig, fm = gid * WGM, gsz = (nM - fm) < WGM ? (nM - fm) : WGM;
        u.pm = fm + ((wgid % nig) % gsz); u.pn = (wgid % nig) / gsz; return true;
    }
};


struct EpiSwiglu {
    static constexpr bool PERM = true;
    bf16_t* U; int ldc;
    DI void operator()(const f32x4 (&acc)[2][2][4][2], const Unit& u, int wr, int wc, int fr, int fq) const {
        const int row0 = u.pm * BM + wr * 64 + fr, col0 = u.pn * 128 + wc * 32 + 8 * fq;
#pragma unroll
        for (int ai = 0; ai < 2; ++ai)
#pragma unroll
            for (int m = 0; m < 4; ++m) {
                bf16_t* rowp = U + (size_t)(row0 + ai * HALF + m * 16) * ldc + col0;
                const f32x4 a0 = acc[ai][0][m][0], a1 = acc[ai][0][m][1], b0 = acc[ai][1][m][0], b1 = acc[ai][1][m][1];
                float v[8];
#pragma unroll
                for (int i = 0; i < 4; ++i) { v[i] = siluf_(a0[i]) * b0[i]; v[4 + i] = siluf_(a1[i]) * b1[i]; }
                u32x4 w; w.x = cvt_pk_bf16(v[0], v[1]); w.y = cvt_pk_bf16(v[2], v[3]); w.z = cvt_pk_bf16(v[4], v[5]); w.w = cvt_pk_bf16(v[6], v[7]);
                *(u32x4*)rowp = w;
            }
    }
};
struct EpiResid {
    static constexpr bool PERM = false;
    const float* base; float* out; const float* gate; float coef; int b0;
    DI void operator()(const f32x4 (&acc)[2][2][4][2], const Unit& u, int wr, int wc, int fr, int fq) const {
        const int row0 = u.pm * BM + wr * 64 + fr, col0 = u.pn * BM + wc * 32 + 4 * fq;
        const float* gp = gate + (size_t)(b0 + (u.pm >> 3)) * NMOD + col0;
        f32x4 gv[2][2];
#pragma unroll
        for (int bj = 0; bj < 2; ++bj)
#pragma unroll
            for (int n = 0; n < 2; ++n) gv[bj][n] = *(const f32x4*)(gp + bj * HALF + n * 16) * coef;
#pragma unroll
        for (int ai = 0; ai < 2; ++ai)
#pragma unroll
            for (int m = 0; m < 4; ++m) {
                const size_t off = (size_t)(row0 + ai * HALF + m * 16) * D + col0;
#pragma unroll
                for (int bj = 0; bj < 2; ++bj)
#pragma unroll
                    for (int n = 0; n < 2; ++n) { const f32x4 x = *(const f32x4*)(base + off + bj * HALF + n * 16); *(f32x4*)(out + off + bj * HALF + n * 16) = x + gv[bj][n] * acc[ai][bj][m][n]; }
            }
    }
};
struct EpiProj {
    static constexpr bool PERM = true;
    bf16_t* P;
    DI void operator()(const f32x4 (&acc)[2][2][4][2], const Unit& u, int wr, int wc, int fr, int fq) const {
        const int row0 = u.pm * BM + wr * 64 + fr, col0 = u.pn * BM + wc * 32 + 8 * fq;
        const int t = u.pn >> 2; const int act = (t == 1) ? 1 : ((t == 4 || t == 5) ? 2 : ((t >= 9) ? 3 : ((t == 6) ? 4 : 0)));
        const float lgh = __builtin_amdgcn_logf(1.f - __builtin_amdgcn_exp2f(-5.f - (float)(u.pn & 3)));
#pragma unroll
        for (int ai = 0; ai < 2; ++ai)
#pragma unroll
            for (int m = 0; m < 4; ++m) {
                bf16_t* rowp = P + (size_t)(row0 + ai * HALF + m * 16) * INW + col0;
#pragma unroll
                for (int bj = 0; bj < 2; ++bj) {
                    f32x4 v0 = acc[ai][bj][m][0], v1 = acc[ai][bj][m][1];
                    if (act == 1) { const float f = 0.0625f * __builtin_amdgcn_exp2f(lgh * (float)(31 - ((row0 + m * 16) & 31))); v0 = v0 * f; v1 = v1 * f; }
                    else if (act == 4) { v0 = v0 * 0.18033688011112042f; v1 = v1 * 0.18033688011112042f; }
                    else if (act == 2) {
#pragma unroll
                        for (int i = 0; i < 4; ++i) { v0[i] = siluf_(v0[i]); v1[i] = siluf_(v1[i]); } }
                    else if (act == 3) {
#pragma unroll
                        for (int i = 0; i < 4; ++i) { v0[i] = sigmoidf_(v0[i]); v1[i] = sigmoidf_(v1[i]); } }
                    u32x4 w; w.x = cvt_pk_bf16(v0[0], v0[1]); w.y = cvt_pk_bf16(v0[2], v0[3]); w.z = cvt_pk_bf16(v1[0], v1[1]); w.w = cvt_pk_bf16(v1[2], v1[3]);
                    *(u32x4*)(rowp + bj * HALF) = w;
                }
            }
    }
};
struct EpiY {
    static constexpr bool PERM = true;
    bf16_t* P; int gcol; int add;
    DI void operator()(const f32x4 (&acc)[2][2][4][2], const Unit& u, int wr, int wc, int fr, int fq) const {
        const int row0 = u.pm * BM + wr * 64 + fr, col0 = u.pn * BM + wc * 32 + 8 * fq;
#pragma unroll
        for (int ai = 0; ai < 2; ++ai)
#pragma unroll
            for (int m = 0; m < 4; ++m) {
                bf16_t* rowp = P + (size_t)(row0 + ai * HALF + m * 16) * INW + col0;
#pragma unroll
                for (int bj = 0; bj < 2; ++bj) {
                    const f32x4 v0 = acc[ai][bj][m][0], v1 = acc[ai][bj][m][1];
                    const u32x4 g = *(const u32x4*)(rowp + gcol + bj * HALF);
                    float o[8];
                    o[0] = bf_lo(g.x) * v0[0]; o[1] = bf_hi(g.x) * v0[1]; o[2] = bf_lo(g.y) * v0[2]; o[3] = bf_hi(g.y) * v0[3];
                    o[4] = bf_lo(g.z) * v1[0]; o[5] = bf_hi(g.z) * v1[1]; o[6] = bf_lo(g.w) * v1[2]; o[7] = bf_hi(g.w) * v1[3];
                    if (add) { const u32x4 y = *(const u32x4*)(rowp + bj * HALF);
                        o[0] += bf_lo(y.x); o[1] += bf_hi(y.x); o[2] += bf_lo(y.y); o[3] += bf_hi(y.y); o[4] += bf_lo(y.z); o[5] += bf_hi(y.z); o[6] += bf_lo(y.w); o[7] += bf_hi(y.w); }
                    u32x4 w; w.x = cvt_pk_bf16(o[0], o[1]); w.y = cvt_pk_bf16(o[2], o[3]); w.z = cvt_pk_bf16(o[4], o[5]); w.w = cvt_pk_bf16(o[6], o[7]);
                    *(u32x4*)(rowp + bj * HALF) = w;
                }
            }
    }
};

template <class Epi, class Sched>
DI void gemm_phase(LAS unsigned char* lds, const Gemm g, const Sched& S, const Epi& E, const int wid) {
    const int lane = olane(), tid = wid * 64 + lane, wr = wid >> 2, wc = wid & 3, fr = lane & 15, fq = lane >> 4;
    const int K = g.K, nt = K / BK;
    unsigned voffA[2], voffB[2];
#pragma unroll
    for (int i = 0; i < 2; ++i) { int R, C; stage_rc(tid * 16 + i * 8192, R, C); const int Rb = Epi::PERM ? ((R & ~31) + perm32(R & 31)) : R;
        voffA[i] = (unsigned)(R * g.lda + C) * 2u; voffB[i] = (unsigned)(Rb * g.ldb + C) * 2u; }
    const size_t kstep = (size_t)(BK * 2);
    const size_t hsA = (size_t)HALF * g.lda * 2, hsB = (size_t)HALF * g.ldb * 2;
    const size_t tsA = 2 * hsA, tsB = 2 * hsB;
    const unsigned ldsw = (unsigned)wid * 1024u;
    const int aoff = lds_byte(wr * 64 + fr, fq * 8), boff = lds_byte(wc * 32 + fr, fq * 8);
#define PG8_SA(b, h) (((b) * 2 + (h)) * HTB)
#define PG8_SB(b, h) ((4 + (b) * 2 + (h)) * HTB)
#define PG8_STAGE(bufoff, gbase, voff) do { _Pragma("unroll") for (int _i = 0; _i < 2; ++_i) \
        __builtin_amdgcn_global_load_lds((const unsigned*)((const char*)(gbase) + (voff)[_i]), (LAS unsigned*)(lds + (bufoff) + ldsw + _i * 8192), 16, 0, 0); } while (0)
#define PG8_LDA(dst, b, h) do { _Pragma("unroll") for (int m = 0; m < 4; ++m) _Pragma("unroll") for (int k = 0; k < 2; ++k) dst[m][k] = *(const LAS bf16x8*)(lds + PG8_SA(b, h) + aoff + m * 2048 + k * 1024); } while (0)
#define PG8_LDB(dst, b, h) do { _Pragma("unroll") for (int n = 0; n < 2; ++n) _Pragma("unroll") for (int k = 0; k < 2; ++k) dst[n][k] = *(const LAS bf16x8*)(lds + PG8_SB(b, h) + boff + n * 2048 + k * 1024); } while (0)
#define PG8_MMA(ai, bj, At, Bt) do { __builtin_amdgcn_s_setprio(1); _Pragma("unroll") for (int m = 0; m < 4; ++m) _Pragma("unroll") for (int n = 0; n < 2; ++n) _Pragma("unroll") for (int k = 0; k < 2; ++k) \
        acc[ai][bj][m][n] = __builtin_amdgcn_mfma_f32_16x16x32_bf16(Bt[n][k], At[m][k], acc[ai][bj][m][n], 0, 0, 0); __builtin_amdgcn_s_setprio(0); } while (0)
#define PG8_WAIT_V(n) asm volatile("s_waitcnt vmcnt(" #n ")" ::: "memory")
#define PG8_WAIT_L(n) asm volatile("s_waitcnt lgkmcnt(" #n ")" ::: "memory")
#define PG8_BAR __builtin_amdgcn_s_barrier()
#define PG8_SCHED __builtin_amdgcn_sched_barrier(0)
    Unit cur, nxt; int ui = 0;
    if (!S.next(0, cur)) return;
    f32x4 acc[2][2][4][2];
#pragma unroll
    for (int a = 0; a < 2; ++a)
#pragma unroll
        for (int b = 0; b < 2; ++b)
#pragma unroll
            for (int m = 0; m < 4; ++m)
#pragma unroll
                for (int n = 0; n < 2; ++n) acc[a][b][m][n] = (f32x4){0.f, 0.f, 0.f, 0.f};
    bf16x8 At[4][2], B0[2][2], B1[2][2];
    const char* cA = (const char*)g.A + (size_t)cur.pm * tsA; const char* cB = (const char*)g.Bt + (size_t)cur.pn * tsB;
    PG8_STAGE(PG8_SB(0, 0), cB, voffB); PG8_STAGE(PG8_SB(0, 1), cB + hsB, voffB); PG8_STAGE(PG8_SA(0, 0), cA, voffA); PG8_STAGE(PG8_SA(0, 1), cA + hsA, voffA);
    if (wr == 1) PG8_BAR;
    PG8_WAIT_V(2); PG8_BAR;
    PG8_STAGE(PG8_SB(1, 0), cB + kstep, voffB); PG8_STAGE(PG8_SA(1, 0), cA + kstep, voffA); PG8_STAGE(PG8_SB(1, 1), cB + hsB + kstep, voffB);
    PG8_WAIT_V(6); PG8_BAR;
    for (;;) {
        const bool has_next = S.next(ui + 1, nxt);
        const char* nA = has_next ? (const char*)g.A + (size_t)nxt.pm * tsA : cA; const char* nB = has_next ? (const char*)g.Bt + (size_t)nxt.pn * tsB : cB;
        for (int t = 0; t < nt; t += 2) {
            const bool last = (t == nt - 2);
            const char* a1 = cA + (size_t)(t + 1) * kstep;
            const char* a2 = last ? nA : cA + (size_t)(t + 2) * kstep; const char* b2 = last ? nB : cB + (size_t)(t + 2) * kstep;
            const char* a3 = a2 + kstep; const char* b3 = b2 + kstep;
            PG8_LDB(B0, 0, 0); PG8_LDB(B1, 0, 1); PG8_SCHED; PG8_LDA(At, 0, 0); PG8_STAGE(PG8_SA(1, 1), a1 + hsA, voffA);
            PG8_WAIT_V(8); PG8_WAIT_L(0); PG8_BAR; PG8_MMA(0, 0, At, B0); PG8_MMA(0, 1, At, B1); PG8_BAR; PG8_SCHED;
            PG8_LDA(At, 0, 1); PG8_STAGE(PG8_SB(0, 0), b2, voffB); PG8_STAGE(PG8_SB(0, 1), b2 + hsB, voffB); PG8_STAGE(PG8_SA(0, 0), a2, voffA);
            PG8_WAIT_V(8); PG8_WAIT_L(0); PG8_BAR; PG8_MMA(1, 0, At, B0); PG8_MMA(1, 1, At, B1); PG8_BAR; PG8_SCHED;
            PG8_LDB(B0, 1, 0); PG8_LDB(B1, 1, 1); PG8_SCHED; PG8_LDA(At, 1, 0); PG8_STAGE(PG8_SA(0, 1), a2 + hsA, voffA);
            PG8_WAIT_V(8); PG8_WAIT_L(0); PG8_BAR; PG8_MMA(0, 0, At, B0); PG8_MMA(0, 1, At, B1); PG8_BAR; PG8_SCHED;
            PG8_LDA(At, 1, 1); PG8_STAGE(PG8_SB(1, 0), b3, voffB); PG8_STAGE(PG8_SB(1, 1), b3 + hsB, voffB); PG8_STAGE(PG8_SA(1, 0), a3, voffA);
            PG8_WAIT_V(8); PG8_WAIT_L(0); PG8_BAR; PG8_MMA(1, 0, At, B0); PG8_MMA(1, 1, At, B1); PG8_BAR; PG8_SCHED;
        }
        if (wr == 0) PG8_BAR;
        E(acc, cur, wr, wc, fr, fq);
        if (!has_next) break;
#pragma unroll
        for (int a = 0; a < 2; ++a)
#pragma unroll
            for (int b = 0; b < 2; ++b)
#pragma unroll
                for (int m = 0; m < 4; ++m)
#pragma unroll
                    for (int n = 0; n < 2; ++n) acc[a][b][m][n] = (f32x4){0.f, 0.f, 0.f, 0.f};
        cur = nxt; cA = nA; cB = nB; ++ui;
        if (wr == 1) PG8_BAR;
    }
    PG8_WAIT_V(0);
    PG8_BAR;
#undef PG8_SA
#undef PG8_SB
#undef PG8_STAGE
#undef PG8_LDA
#undef PG8_LDB
#undef PG8_MMA
#undef PG8_WAIT_V
#undef PG8_WAIT_L
#undef PG8_BAR
#undef PG8_SCHED
}
}

namespace att {
typedef short v4i16_t __attribute__((ext_vector_type(4)));
DI int fsw(int row) { return ((row & 3) << 2) | ((row >> 2) & 3); }
DI s16x4 vtr(LAS const unsigned char* p) { return __builtin_bit_cast(s16x4, __builtin_amdgcn_ds_read_tr16_b64_v4i16((LAS v4i16_t*)p)); }
DI void dma16(const void* g, LAS unsigned char* l) { __builtin_amdgcn_global_load_lds((const unsigned*)g, (LAS unsigned*)l, 16, 0, 0); }
#define MFMA32(a, b, c) __builtin_amdgcn_mfma_f32_32x32x16_bf16((a), (b), (c), 0, 0, 0)
DI bf16x8 pack8(const f32x16& x, int s8) {
    u32x4 p; p.x = cvt_pk_bf16(x[s8 + 0], x[s8 + 1]); p.y = cvt_pk_bf16(x[s8 + 2], x[s8 + 3]); p.z = cvt_pk_bf16(x[s8 + 4], x[s8 + 5]); p.w = cvt_pk_bf16(x[s8 + 6], x[s8 + 7]);
    return __builtin_bit_cast(bf16x8, p);
}
#define WAITV0() asm volatile("s_waitcnt vmcnt(0)" ::: "memory")

template <bool DIAG>
DI void diff_tile(f32x16 (&o)[4], float& mrun, float& lrun, bool& first, const bf16x8 (&qf)[4], LAS unsigned char* lds, const int bufi, const unsigned K0, const unsigned V0a, const unsigned V0b,
                  const int t, const int iq, const int h, const int q0, const float c2, const float c2x5) {
#define DV_LOAD(L, Hh, g_) do { _Pragma("unroll") for (int e2 = 0; e2 < 2; ++e2) { L[e2] = vtr((LAS const unsigned char*)(size_t)(va0 ^ (64 * (2 * ((g_) & 1) + e2))) + 4096 * ((g_) >> 1)); Hh[e2] = vtr((LAS const unsigned char*)(size_t)(va1 ^ (64 * (2 * ((g_) & 1) + e2))) + 4096 * ((g_) >> 1)); } } while (0)
#define DV_MMA(L, Hh, g_) do { _Pragma("unroll") for (int e2 = 0; e2 < 2; ++e2) { const bf16x8 vf = __builtin_shufflevector(L[e2], Hh[e2], 0, 1, 2, 3, 4, 5, 6, 7); o[2 * ((g_) & 1) + e2] = MFMA32(vf, pf[(g_) >> 1], o[2 * ((g_) & 1) + e2]); } } while (0)
            const unsigned kbase = (unsigned)(size_t)lds + (bufi) * 32768;
            const unsigned ka = opqv(kbase + K0), va0 = opqv(kbase + 16384 + V0a), va1 = opqv(kbase + 16384 + V0b);
            const float base = (float)(64 * t + 4 * h - iq) * c2 - mrun;
            f32x16 st[2];
            { float bv = base;
#pragma unroll
              for (int kb = 0; kb < 2; ++kb)
#pragma unroll
                  for (int i = 0; i < 16; ++i) { st[kb][i] = bv; bv = ((i & 3) == 3) ? __builtin_fmaf(c2, 5.f, bv) : bv + c2; } }
            { bf16x8 kf[8];
#pragma unroll
              for (int kb = 0; kb < 2; ++kb)
#pragma unroll
                  for (int ks = 0; ks < 4; ++ks) kf[kb * 4 + ks] = *(const LAS bf16x8*)((size_t)(ka ^ (32 * ks)) + kb * 8192);
              __builtin_amdgcn_sched_barrier(0);
#pragma unroll
              for (int ks = 0; ks < 4; ++ks)
#pragma unroll
                  for (int kb = 0; kb < 2; ++kb) st[kb] = MFMA32(kf[kb * 4 + ks], qf[ks], st[kb]); }
            s16x4 vl0[2], vh0[2], vl1[2], vh1[2];
            __builtin_amdgcn_sched_barrier(0);
            DV_LOAD(vl0, vh0, 0);
            __builtin_amdgcn_sched_barrier(0);
            if (DIAG && 64 * t + 63 > q0) {
                const int lim = iq - 64 * t - 4 * h;
#pragma unroll
                for (int kb = 0; kb < 2; ++kb)
#pragma unroll
                    for (int i = 0; i < 16; ++i) if (32 * kb + (i & 3) + 8 * (i >> 2) > lim) st[kb][i] = -INFINITY;
            }
            float mx = fmaxf(st[0][0], st[1][0]);
#pragma unroll
            for (int i = 1; i < 16; ++i) mx = fmaxf(mx, fmaxf(st[0][i], st[1][i]));
            mx = xhalf_max(mx);
            if (DIAG && first) {
                first = false; mrun = mx;
#pragma unroll
                for (int kb = 0; kb < 2; ++kb)
#pragma unroll
                    for (int i = 0; i < 16; ++i) st[kb][i] -= mx;
            } else if (__any(mx > 5.f)) {
                const float dl = fmaxf(mx, 0.f), alpha = __builtin_amdgcn_exp2f(-dl);
                mrun += dl; lrun *= alpha;
#pragma unroll
                for (int kb = 0; kb < 2; ++kb)
#pragma unroll
                    for (int i = 0; i < 16; ++i) st[kb][i] -= dl;
#pragma unroll
                for (int eb = 0; eb < 4; ++eb) o[eb] = o[eb] * alpha;
            }
            float ls = 0.f;
#pragma unroll
            for (int kb = 0; kb < 2; ++kb)
#pragma unroll
                for (int i = 0; i < 16; ++i) { const float p = __builtin_amdgcn_exp2f(st[kb][i]); st[kb][i] = p; ls += p; }
            lrun += ls;
            bf16x8 pf[4];
#pragma unroll
            for (int s = 0; s < 4; ++s) pf[s] = pack8(st[s >> 1], 8 * (s & 1));
            __builtin_amdgcn_sched_barrier(0);
            DV_LOAD(vl1, vh1, 1); __builtin_amdgcn_sched_barrier(0); DV_MMA(vl0, vh0, 0); __builtin_amdgcn_sched_barrier(0);
            DV_LOAD(vl0, vh0, 2); __builtin_amdgcn_sched_barrier(0); DV_MMA(vl1, vh1, 1); __builtin_amdgcn_sched_barrier(0);
            DV_LOAD(vl1, vh1, 3); __builtin_amdgcn_sched_barrier(0); DV_MMA(vl0, vh0, 2); __builtin_amdgcn_sched_barrier(0);
            DV_LOAD(vl0, vh0, 4); __builtin_amdgcn_sched_barrier(0); DV_MMA(vl1, vh1, 3); __builtin_amdgcn_sched_barrier(0);
            DV_LOAD(vl1, vh1, 5); __builtin_amdgcn_sched_barrier(0); DV_MMA(vl0, vh0, 4); __builtin_amdgcn_sched_barrier(0);
            DV_LOAD(vl0, vh0, 6); __builtin_amdgcn_sched_barrier(0); DV_MMA(vl1, vh1, 5); __builtin_amdgcn_sched_barrier(0);
            DV_LOAD(vl1, vh1, 7); __builtin_amdgcn_sched_barrier(0); DV_MMA(vl0, vh0, 6); __builtin_amdgcn_sched_barrier(0);
            DV_MMA(vl1, vh1, 7);
#undef DV_LOAD
#undef DV_MMA
}
DI void diff_unit(LAS unsigned char* lds, bf16_t* P, int b, int head, int qb, const LAS float* lamp, const float* subln, const int wid) {
    const int lane = olane(), r = lane & 31, h = lane >> 5;
    const int mp = wid >> 2, qg = wid & 3, q0 = 128 * qb + 32 * qg, iq = q0 + r;
    bf16_t* rowb = P + (size_t)b * SEQ * INW;
    bf16x8 qf[4];
    { const bf16_t* qp = rowb + (size_t)iq * INW + C_DQ + head * 128 + mp * 64 + 8 * h;
#pragma unroll
      for (int ks = 0; ks < 4; ++ks) qf[ks] = *(const bf16x8*)(qp + 16 * ks); }
    const int NT = 2 * (qb + 1);
    unsigned koff[2], voff[2];
#pragma unroll
    for (int i = 0; i < 2; ++i) { const int L = wid * 2 + i, row = 4 * L + (lane >> 4), p = lane & 15, ch = p ^ fsw(row);
        koff[i] = (unsigned)(row * INW + C_DK + head * 128 + ch * 8) * 2u; voff[i] = (unsigned)(row * INW + C_DV + head * 128 + ch * 8) * 2u; }
    const char* gb = (const char*)rowb;
    const float slope = __builtin_amdgcn_exp2f(-(float)(head + 1));
    const float c2 = slope * 1.4426950408889634f, c2x5 = 5.f * c2;
    const int fr_ = fsw(r);
    const unsigned K0 = 256 * r + 16 * ((8 * mp + h) ^ fr_);
    const int i16 = lane & 15, q4 = i16 >> 2, p4 = i16 & 3, gg = (lane >> 4) & 1;
    int vlow[2], ebx[4];
#pragma unroll
    for (int jh = 0; jh < 2; ++jh) vlow[jh] = 256 * (8 * jh + 4 * h + q4) + 16 * ((2 * gg + (p4 >> 1)) ^ (2 * jh + h)) + 8 * (p4 & 1);
#pragma unroll
    for (int eb = 0; eb < 4; ++eb) ebx[eb] = 64 * (eb ^ q4);
    const unsigned V0a = vlow[0] + 64 * q4, V0b = vlow[1] + 64 * q4;
    f32x16 o[4];
#pragma unroll
    for (int eb = 0; eb < 4; ++eb) o[eb] = zero16();
    float mrun = 0.f, lrun = 0.f; bool first = true;
#define DIFF_DMA(t, bi) do { const char* src_ = gb + (size_t)(t) * 64 * INW * 2; _Pragma("unroll") for (int i_ = 0; i_ < 2; ++i_) { \
        dma16(src_ + koff[i_], lds + (bi) * 32768 + (wid * 2 + i_) * 1024); dma16(src_ + voff[i_], lds + (bi) * 32768 + 16384 + (wid * 2 + i_) * 1024); } } while (0)
    WAITV0();
    DIFF_DMA(NT - 1, 0); DIFF_DMA(NT - 2, 1); if (NT > 2) DIFF_DMA(NT - 3, 2);
    for (int it = 0; it < 2; ++it) {
        const int t = NT - 1 - it;
        if (it + 2 < NT) asm volatile("s_waitcnt vmcnt(8)\n\ts_barrier" ::: "memory");
        else if (it + 1 < NT) asm volatile("s_waitcnt vmcnt(4)\n\ts_barrier" ::: "memory");
        else asm volatile("s_waitcnt vmcnt(0)\n\ts_barrier" ::: "memory");
        if (it + 3 < NT) DIFF_DMA(t - 3, (it + 3) & 3);
        if (64 * t <= q0 + 31) diff_tile<true>(o, mrun, lrun, first, qf, lds, it & 3, K0, V0a, V0b, t, iq, h, q0, c2, c2x5);
    }
    for (int it = 2; it < NT; ++it) {
        const int t = NT - 1 - it;
        if (it + 2 < NT) asm volatile("s_waitcnt vmcnt(8)\n\ts_barrier" ::: "memory");
        else if (it + 1 < NT) asm volatile("s_waitcnt vmcnt(4)\n\ts_barrier" ::: "memory");
        else asm volatile("s_waitcnt vmcnt(0)\n\ts_barrier" ::: "memory");
        if (it + 3 < NT) DIFF_DMA(t - 3, (it + 3) & 3);
        diff_tile<false>(o, mrun, lrun, first, qf, lds, it & 3, K0, V0a, V0b, t, iq, h, q0, c2, c2x5);
    }
#undef DIFF_DMA
    { const float lt = xhalf_sum(lrun), inv = 1.f / lt;
#pragma unroll
      for (int eb = 0; eb < 4; ++eb) o[eb] = o[eb] * inv; }
    __syncthreads();
    LAS float* X = (LAS float*)(lds + qg * 16384);
    const int lane3 = olane();
    if (mp == 1) {
#pragma unroll
        for (int eb = 0; eb < 4; ++eb)
#pragma unroll
            for (int i = 0; i < 16; ++i) X[(eb * 16 + i) * 64 + lane3] = o[eb][i];
    }
    __syncthreads();
    if (mp == 0) {
        const int lane2 = olane(), h2 = lane2 >> 5, iq2 = q0 + (lane2 & 31);
        const float lam = lamp[0];
        float ss = 0.f;
#pragma unroll
        for (int eb = 0; eb < 4; ++eb)
#pragma unroll
            for (int i = 0; i < 16; ++i) { const float d = o[eb][i] - lam * X[(eb * 16 + i) * 64 + lane2]; o[eb][i] = d; ss += d * d; }
        ss = xhalf_sum(ss);
        const float rs = __builtin_amdgcn_rsqf(ss * (1.f / 128.f) + EPS) * 0.8f;
        bf16_t* op = rowb + (size_t)iq2 * INW + C_DQ + head * 128 + 4 * h2;
#pragma unroll
        for (int eb = 0; eb < 4; ++eb)
#pragma unroll
            for (int g4 = 0; g4 < 4; ++g4) { const int e = 32 * eb + 8 * g4; const f32x4 w = *(const f32x4*)(subln + e + 4 * h2);
                u32x2 v; v.x = cvt_pk_bf16(o[eb][4 * g4 + 0] * rs * w[0], o[eb][4 * g4 + 1] * rs * w[1]); v.y = cvt_pk_bf16(o[eb][4 * g4 + 2] * rs * w[2], o[eb][4 * g4 + 3] * rs * w[3]);
                *(u32x2*)(op + e) = v; }
    }
    __syncthreads();
}

DI void ret_unit(LAS unsigned char* lds, bf16_t* P, int b, int head, int qb, const int wid) {
    const int lane = olane(), r = lane & 31, h = lane >> 5;
    const int hh = wid >> 2, qg = wid & 3, q0 = 128 * qb + 32 * qg, iq = q0 + r;
    bf16_t* rowb = P + (size_t)b * SEQ * INW;
    bf16x8 qf[8];
    { const bf16_t* qp = rowb + (size_t)iq * INW + C_RQ + head * 256 + 128 * hh + 8 * h;
#pragma unroll
      for (int ks = 0; ks < 8; ++ks) qf[ks] = *(const bf16x8*)(qp + 16 * ks); }
    const int NT = 4 * (qb + 1);
    unsigned goff[6];
#pragma unroll
    for (int i = 0; i < 6; ++i) { const int L = wid * 6 + i;
        if (L < 16) { const int row = 2 * L + (lane >> 5), pos = lane & 31, ch = (pos & 16) + ((pos & 15) ^ fsw(row)); goff[i] = (unsigned)(row * INW + C_RK + head * 256 + ch * 8) * 2u; }
        else { const int row = L - 16, ch = (lane & 48) + ((lane & 15) ^ fsw(row)); goff[i] = (unsigned)(row * INW + C_RV + head * 512 + ch * 8) * 2u; } }
    const char* gb = (const char*)rowb;
    const float lg = __builtin_amdgcn_logf(1.f - __builtin_amdgcn_exp2f(-5.f - (float)head));
    const int fr_ = fsw(r);
    const int i16 = lane & 15, q4 = i16 >> 2, p4 = i16 & 3, gg = (lane >> 4) & 1;
    const unsigned V0a = 1024 * (4 * h + q4) + 16 * ((2 * gg + (p4 >> 1)) ^ h) + 8 * (p4 & 1) + 512 * hh + 64 * q4;
    const unsigned V0b = 1024 * (8 + 4 * h + q4) + 16 * ((2 * gg + (p4 >> 1)) ^ (2 + h)) + 8 * (p4 & 1) + 512 * hh + 64 * q4;
    const unsigned K0 = 512 * r + 256 * hh + 16 * (h ^ fr_);
    const unsigned xs_w = (unsigned)(size_t)lds + 98304 + wid * 2048 + lane * 16, xs_r = (unsigned)(size_t)lds + 98304 + (wid ^ 4) * 2048 + lane * 16;
    f32x16 o[8];
#pragma unroll
    for (int eb = 0; eb < 8; ++eb) o[eb] = zero16();
#define RET_DMA_K(t, bi) do { const char* src_ = gb + (size_t)(t) * 32 * INW * 2; _Pragma("unroll") for (int i_ = 0; i_ < 6; ++i_) if (wid * 6 + i_ < 16) dma16(src_ + goff[i_], lds + (bi) * 16384 + (wid * 6 + i_) * 1024); } while (0)
#define RET_DMA_V(t, bi) do { const char* src_ = gb + (size_t)(t) * 32 * INW * 2; _Pragma("unroll") for (int i_ = 0; i_ < 6; ++i_) if (wid * 6 + i_ >= 16) dma16(src_ + goff[i_], lds + 32768 + (bi) * 32768 + (wid * 6 + i_ - 16) * 1024); } while (0)
#define RET_QK(dst, bi) do { const unsigned ka_ = opqv((unsigned)(size_t)lds + (bi) * 16384 + K0); bf16x8 kf_[8]; \
        _Pragma("unroll") for (int ks = 0; ks < 8; ++ks) kf_[ks] = *(const LAS bf16x8*)(size_t)(ka_ ^ (32 * ks)); \
        _Pragma("unroll") for (int ks = 0; ks < 8; ++ks) dst = MFMA32(kf_[ks], qf[ks], dst); } while (0)
#define RET_XW(src, bi) do { u32x4 w0_, w1_; w0_.x = cvt_pk_bf16(src[0], src[1]); w0_.y = cvt_pk_bf16(src[2], src[3]); w0_.z = cvt_pk_bf16(src[4], src[5]); w0_.w = cvt_pk_bf16(src[6], src[7]); \
        w1_.x = cvt_pk_bf16(src[8], src[9]); w1_.y = cvt_pk_bf16(src[10], src[11]); w1_.z = cvt_pk_bf16(src[12], src[13]); w1_.w = cvt_pk_bf16(src[14], src[15]); \
        *(LAS u32x4*)(size_t)(xs_w + (bi) * 16384) = w0_; *(LAS u32x4*)(size_t)(xs_w + (bi) * 16384 + 1024) = w1_; } while (0)
    WAITV0();
    RET_DMA_K(0, 0); RET_DMA_V(0, 0); RET_DMA_K(1, 1);
    asm volatile("s_waitcnt vmcnt(0) lgkmcnt(0)\n\ts_barrier" ::: "memory");
    f32x16 sown = zero16();
    RET_QK(sown, 0);
    RET_XW(sown, 0);
    for (int t = 0; t < NT; ++t) {
        asm volatile("s_waitcnt vmcnt(0) lgkmcnt(0)\n\ts_barrier" ::: "memory");
        if (t + 1 < NT) RET_DMA_V(t + 1, (t + 1) & 1);
        if (t + 2 < NT) RET_DMA_K(t + 2, t & 1);
        const bool live_t = (32 * t <= q0 + 31), live_n = (t + 1 < NT) && (32 * (t + 1) <= q0 + 31);
        f32x16 snext = zero16();
        if (live_n) RET_QK(snext, (t + 1) & 1);
        if (live_t) {
            const unsigned va0 = opqv((unsigned)(size_t)lds + 32768 + (t & 1) * 32768 + V0a), va1 = opqv((unsigned)(size_t)lds + 32768 + (t & 1) * 32768 + V0b);
            const u32x4 x0 = *(const LAS u32x4*)(size_t)(xs_r + (t & 1) * 16384), x1 = *(const LAS u32x4*)(size_t)(xs_r + (t & 1) * 16384 + 1024);
            const float rowf = __builtin_amdgcn_exp2f(lg * (float)(iq - 32 * t - 31));
            f32x16 st;
            st[0] = sown[0] + bf_lo(x0.x); st[1] = sown[1] + bf_hi(x0.x); st[2] = sown[2] + bf_lo(x0.y); st[3] = sown[3] + bf_hi(x0.y);
            st[4] = sown[4] + bf_lo(x0.z); st[5] = sown[5] + bf_hi(x0.z); st[6] = sown[6] + bf_lo(x0.w); st[7] = sown[7] + bf_hi(x0.w);
            st[8] = sown[8] + bf_lo(x1.x); st[9] = sown[9] + bf_hi(x1.x); st[10] = sown[10] + bf_lo(x1.y); st[11] = sown[11] + bf_hi(x1.y);
            st[12] = sown[12] + bf_lo(x1.z); st[13] = sown[13] + bf_hi(x1.z); st[14] = sown[14] + bf_lo(x1.w); st[15] = sown[15] + bf_hi(x1.w);
#pragma unroll
            for (int i = 0; i < 16; ++i) st[i] *= rowf;
            if (32 * t + 31 > q0) {
                const int lim = iq - 32 * t - 4 * h;
#pragma unroll
                for (int i = 0; i < 16; ++i) if ((i & 3) + 8 * (i >> 2) > lim) st[i] = 0.f;
            }
            bf16x8 pf[2];
            pf[0] = pack8(st, 0); pf[1] = pack8(st, 8);
            s16x4 vl0[2], vh0[2], vl1[2], vh1[2];
#define RV_LOAD(L, Hh, g_) do { _Pragma("unroll") for (int e2 = 0; e2 < 2; ++e2) { const int eb_ = 2 * ((g_) & 3) + e2; L[e2] = vtr((LAS const unsigned char*)(size_t)(va0 ^ (64 * (eb_ & 3))) + 256 * (eb_ >> 2) + 16384 * ((g_) >> 2)); Hh[e2] = vtr((LAS const unsigned char*)(size_t)(va1 ^ (64 * (eb_ & 3))) + 256 * (eb_ >> 2) + 16384 * ((g_) >> 2)); } } while (0)
#define RV_MMA(L, Hh, g_) do { _Pragma("unroll") for (int e2 = 0; e2 < 2; ++e2) { const int eb_ = 2 * ((g_) & 3) + e2; const bf16x8 vf = __builtin_shufflevector(L[e2], Hh[e2], 0, 1, 2, 3, 4, 5, 6, 7); o[eb_] = MFMA32(vf, pf[(g_) >> 2], o[eb_]); } } while (0)
            RV_LOAD(vl0, vh0, 0);
            RV_LOAD(vl1, vh1, 1); RV_MMA(vl0, vh0, 0);
            RV_LOAD(vl0, vh0, 2); RV_MMA(vl1, vh1, 1);
            RV_LOAD(vl1, vh1, 3); RV_MMA(vl0, vh0, 2);
            RV_LOAD(vl0, vh0, 4); RV_MMA(vl1, vh1, 3);
            RV_LOAD(vl1, vh1, 5); RV_MMA(vl0, vh0, 4);
            RV_LOAD(vl0, vh0, 6); RV_MMA(vl1, vh1, 5);
            RV_LOAD(vl1, vh1, 7); RV_MMA(vl0, vh0, 6);
            RV_MMA(vl1, vh1, 7);
#undef RV_LOAD
#undef RV_MMA
        }
        if (live_n) RET_XW(snext, (t + 1) & 1);
        sown = snext;
    }
#undef RET_DMA_K
#undef RET_DMA_V
#undef RET_QK
#undef RET_XW
    float s1 = 0.f, s2 = 0.f;
#pragma unroll
    for (int eb = 0; eb < 8; ++eb)
#pragma unroll
        for (int i = 0; i < 16; ++i) { const float v = o[eb][i]; s1 += v; s2 += v * v; }
    s1 = xhalf_sum(s1); s2 = xhalf_sum(s2);
    __syncthreads();
    LAS float* ST = (LAS float*)lds;
    const int lane2 = olane(), r2 = lane2 & 31, h2 = lane2 >> 5, iq2 = q0 + r2;
    if (h2 == 0) { ST[(wid * 32 + r2) * 2] = s1; ST[(wid * 32 + r2) * 2 + 1] = s2; }
    __syncthreads();
    { const float t1 = s1 + ST[((wid ^ 4) * 32 + r2) * 2], t2 = s2 + ST[((wid ^ 4) * 32 + r2) * 2 + 1];
      const float mean = t1 * (1.f / 512.f); const float var = fmaxf(t2 * (1.f / 512.f) - mean * mean, 0.f);
      const float rstd = __builtin_amdgcn_rsqf(var + EPS);
      bf16_t* op = rowb + (size_t)iq2 * INW + C_RG + head * 512 + 256 * hh + 4 * h2;
#pragma unroll
      for (int eb = 0; eb < 8; ++eb)
#pragma unroll
          for (int g4 = 0; g4 < 4; ++g4) { bf16_t* pp = op + 32 * eb + 8 * g4; const u32x2 gq = *(const u32x2*)pp;
              u32x2 v; v.x = cvt_pk_bf16((o[eb][4 * g4 + 0] - mean) * rstd * bf_lo(gq.x), (o[eb][4 * g4 + 1] - mean) * rstd * bf_hi(gq.x));
              v.y = cvt_pk_bf16((o[eb][4 * g4 + 2] - mean) * rstd * bf_lo(gq.y), (o[eb][4 * g4 + 3] - mean) * rstd * bf_hi(gq.y));
              *(u32x2*)pp = v; } }
    __syncthreads();
}
}

DI void tr_item(const float* W, int K, int N, bf16_t* WT, int mode, LAS float* scr, int item, int lane) {
    const int nblk = N / 32, kb = item / nblk, nb = item % nblk, k0 = 64 * kb, n0 = 32 * nb;
    int rowbase = n0;
    if (mode) { const int which = n0 / FF, j = n0 - which * FF; rowbase = 256 * (j / 128) + 128 * which + (j % 128); }
#pragma unroll 8
    for (int i = 0; i < 32; ++i) { const int kk = 2 * i + (lane >> 5); scr[kk * 33 + (lane & 31)] = W[(size_t)(k0 + kk) * N + n0 + (lane & 31)]; }
    asm volatile("s_waitcnt lgkmcnt(0)" ::: "memory");
    const int c = lane & 7;
#pragma unroll
    for (int j = 0; j < 4; ++j) { const int n = (lane >> 3) + 8 * j; const LAS float* s = scr + (8 * c) * 33 + n;
        u32x4 o; o.x = cvt_pk_bf16(s[0 * 33], s[1 * 33]); o.y = cvt_pk_bf16(s[2 * 33], s[3 * 33]); o.z = cvt_pk_bf16(s[4 * 33], s[5 * 33]); o.w = cvt_pk_bf16(s[6 * 33], s[7 * 33]);
        *(u32x4*)(WT + (size_t)(rowbase + n) * K + k0 + 8 * c) = o; }
    asm volatile("s_waitcnt lgkmcnt(0)" ::: "memory");
}
DI void modulate_rows(const float* X, const float* g, const float* modsub, bf16_t* H, int ngw, const int wid) {
    const int lane = olane(), gw = opqi(blockIdx.x * 8 + wid);
    for (int m = gw; m < M; m += ngw) {
        const float* shift = modsub + (size_t)(m >> 11) * NMOD; const float* scale = shift + D;
        const f32x4* xr = (const f32x4*)(X + (size_t)m * D) + lane;
        f32x4 v[4]; float ss = 0.f;
#pragma unroll
        for (int j = 0; j < 4; ++j) { v[j] = xr[64 * j]; ss += (v[j].x * v[j].x + v[j].y * v[j].y) + (v[j].z * v[j].z + v[j].w * v[j].w); }
        const float rstd = __builtin_amdgcn_rsqf(wave_sum(ss) * (1.f / D) + EPS);
#pragma unroll
        for (int j = 0; j < 4; ++j) { const int k = 4 * (lane + 64 * j);
            const f32x4 gv = *(const f32x4*)(g + k), sc = *(const f32x4*)(scale + k), sh = *(const f32x4*)(shift + k);
            const f32x4 y = (v[j] * rstd * gv) * (sc + 1.f) + sh;
            u32x2 w; w.x = cvt_pk_bf16(y.x, y.y); w.y = cvt_pk_bf16(y.z, y.w);
            *(u32x2*)(H + (size_t)m * D + k) = w; }
    }
}

#define XB_TMO      128
#define XB_XCNT(j)  (256  + 64 * (j))
#define XB_XSUB(j)  (1280 + 64 * (j))
#define XB_XGEN(j)  (2304 + 64 * (j))
#define XB_TOP      3328
#define XB_TOPGEN   3392
#define XCD_BAR_WORDS 3456
#define XB_SPIN_CAP (1u << 18)
DI unsigned xb_ld(unsigned* p)              { return __hip_atomic_load(p, __ATOMIC_RELAXED, __HIP_MEMORY_SCOPE_AGENT); }
DI unsigned xb_add(unsigned* p, unsigned v) { return __hip_atomic_fetch_add(p, v, __ATOMIC_RELAXED, __HIP_MEMORY_SCOPE_AGENT); }
DI unsigned xb_xcc_id() { return (unsigned)__builtin_amdgcn_s_getreg((3 << 11) | 20) & 0xFu; }
#define XB_SPIN(cond, bar) do { unsigned _sp = 0; while (cond) { __builtin_amdgcn_s_sleep(1); \
    if ((++_sp & 255u) == 0u) { if (xb_ld(&(bar)[XB_TMO])) break; if (_sp > XB_SPIN_CAP) { atomicAdd(&(bar)[XB_TMO], 1u); break; } } } } while (0)
struct XcdBarrier { unsigned* bar; unsigned x; volatile LAS unsigned* st; };
DI XcdBarrier xcd_barrier_post(unsigned* bar, volatile LAS unsigned* st, bool lead) {
    XcdBarrier b; b.bar = bar; b.x = xb_xcc_id(); b.st = st;
    if (lead) (void)xb_add(&bar[XB_XCNT(b.x)], 1u);
    return b;
}
DI void xcd_barrier_complete(unsigned* bar, unsigned x, unsigned& nloc, unsigned& nx) {
    const unsigned G = gridDim.x * gridDim.y * gridDim.z;
    unsigned sum, cnt, mine, sp = 0u;
    for (;;) {
        sum = 0u; cnt = 0u; mine = 0u;
#pragma unroll
        for (unsigned j = 0; j < 16; ++j) { const unsigned c = xb_ld(&bar[XB_XCNT(j)]); sum += c; cnt += (c > 0u) ? 1u : 0u; mine = (j == x) ? c : mine; }
        if (sum == G) break;
        __builtin_amdgcn_s_sleep(1);
        if ((++sp & 255u) == 0u) { if (xb_ld(&bar[XB_TMO])) break; if (sp > XB_SPIN_CAP) { atomicAdd(&bar[XB_TMO], 1u); break; } }
    }
    nloc = mine > 0u ? mine : 1u; nx = cnt > 0u ? cnt : 1u;
}
DI void xcd_barrier(const XcdBarrier& b, bool lead) {
    asm volatile("s_waitcnt vmcnt(0)" ::: "memory");
    __syncthreads();
    if (lead) {
        unsigned* bar = b.bar;
        __builtin_amdgcn_s_waitcnt(0);
        unsigned nloc = b.st[0], nx = b.st[1];
        if (nloc == 0u) { xcd_barrier_complete(bar, b.x, nloc, nx); b.st[0] = nloc; b.st[1] = nx; }
        const unsigned old = xb_add(&bar[XB_XSUB(b.x)], 1u);
        const unsigned gen = old / nloc;
        if (old + 1u == (gen + 1u) * nloc) {
            __builtin_amdgcn_fence(__ATOMIC_RELEASE, "agent");
            asm volatile("s_waitcnt vmcnt(0)" ::: "memory");
            const unsigned og = xb_add(&bar[XB_TOP], 1u);
            const unsigned tg = og / nx;
            if (og + 1u == (tg + 1u) * nx) xb_add(&bar[XB_TOPGEN], 1u);
            else XB_SPIN(xb_ld(&bar[XB_TOPGEN]) == tg, bar);
            __builtin_amdgcn_fence(__ATOMIC_ACQUIRE, "agent");
            xb_add(&bar[XB_XGEN(b.x)], 1u);
            asm volatile("s_waitcnt vmcnt(0)" ::: "memory");
        } else {
            XB_SPIN(xb_ld(&bar[XB_XGEN(b.x)]) == gen, bar);
            __builtin_amdgcn_fence(__ATOMIC_ACQUIRE, "agent");
            asm volatile("s_waitcnt vmcnt(0)" ::: "memory");
        }
    }
    __syncthreads();
}

struct Args { const float* in[16]; float* out; unsigned char* ws; };

__global__ void __launch_bounds__(512, 2) mega(Args a) {
    extern __shared__ __attribute__((aligned(16))) unsigned char lds_raw[];
    LAS unsigned char* lds = (LAS unsigned char*)lds_raw;
    cg::grid_group grid = cg::this_grid();
    const int wid = __builtin_amdgcn_readfirstlane((int)threadIdx.x >> 6);
    const int G = gridDim.x, ngw = G * 8;
    unsigned char* ws = a.ws;
    const float* x_in = a.in[0];
    float* out = a.out;
#define mod ((float*)(opq(ws) + WS_MOD))
#define ctl ((unsigned*)(opq(ws) + WS_CTL))
#define W1I ((bf16_t*)(opq(ws) + WS_W1I))
#define W1O ((bf16_t*)(opq(ws) + WS_W1O))
#define WIN ((bf16_t*)(opq(ws) + WS_WIN))
#define WRO ((bf16_t*)(opq(ws) + WS_WRO))
#define WDO ((bf16_t*)(opq(ws) + WS_WDO))
#define WO ((bf16_t*)(opq(ws) + WS_WO))
#define H ((bf16_t*)(opq(ws) + WS_H))
#define BIG ((bf16_t*)(opq(ws) + WS_BIG))
    LAS unsigned* sflag = (LAS unsigned*)(lds + 131072);
    if (wid == 0) { const int l0 = olane(); if (l0 < 8) sflag[l0] = 0u; }
    __syncthreads();
    const XcdBarrier xbar = xcd_barrier_post((unsigned*)(ws + WS_BAR), (volatile LAS unsigned*)(sflag + 2), wid == 0 && olane() == 0);
#define GSYNC() xcd_barrier(xbar, wid == 0 && olane() == 0)

    for (int item = blockIdx.x; item < NMOD / 64; item += G) {
        const int lane = olane(), tid = wid * 64 + lane;
        LAS float* cs = (LAS float*)lds; LAS float* red = (LAS float*)(lds + 32768);
        for (int i = tid; i < NB * D; i += 512) cs[i] = siluf_(a.in[1][i]);
        __syncthreads();
        const int col = item * 64 + lane, k0 = wid * 128;
        float acc[8];
#pragma unroll
        for (int b = 0; b < 8; ++b) acc[b] = 0.f;
        const float* wp = a.in[2] + (size_t)k0 * NMOD + col;
#pragma unroll 8
        for (int k = 0; k < 128; ++k) { const float w = wp[(size_t)k * NMOD];
#pragma unroll
            for (int b = 0; b < 8; ++b) acc[b] += cs[b * D + k0 + k] * w; }
#pragma unroll
        for (int b = 0; b < 8; ++b) red[(wid * 8 + b) * 64 + lane] = acc[b];
        __syncthreads();
        { float s = 0.f;
#pragma unroll
          for (int w = 0; w < 8; ++w) s += red[(w * 8 + wid) * 64 + lane];
          mod[(size_t)wid * NMOD + col] = s + a.in[3][col]; }
        __syncthreads();
    }
    {
        const int lane = olane(), gw = opqi(blockIdx.x * 8 + wid);
        LAS float* scr = (LAS float*)(lds + wid * 16384);
        constexpr int I_FI = (D / 64) * (2 * FF / 32), I_FO = (FF / 64) * (D / 32), I_IN = (D / 64) * (INW / 32), I_RO = (2048 / 64) * (D / 32), I_DO = (D / 64) * (D / 32);
        constexpr int NIT = I_FI + I_FO + I_IN + I_RO + 2 * I_DO;
        for (int it = gw; it < NIT; it += ngw) {
            int r = it;
            if (r < I_FI) { tr_item(a.in[5], D, 2 * FF, W1I, 1, scr, r, lane); continue; } r -= I_FI;
            if (r < I_FO) { tr_item(a.in[6], FF, D, W1O, 0, scr, r, lane); continue; } r -= I_FO;
            if (r < I_IN) { tr_item(a.in[7], D, INW, WIN, 0, scr, r, lane); continue; } r -= I_IN;
            if (r < I_RO) { tr_item(a.in[8], 2048, D, WRO, 0, scr, r, lane); continue; } r -= I_RO;
            if (r < I_DO) { tr_item(a.in[11], D, D, WDO, 0, scr, r, lane); continue; } r -= I_DO;
            tr_item(a.in[12], D, D, WO, 0, scr, r, lane);
        }
    }
    grid.sync();

#pragma unroll 1
    for (int stage = 0; stage < 2; ++stage) {
        modulate_rows(stage == 0 ? x_in : out, a.in[4] + (stage == 0 ? 0 : 2 * D), mod + (stage == 0 ? 0 : 2 * 3 * D), H, ngw, wid);
        GSYNC();
        { pg8::Gemm g{H, W1I, M, 2 * FF, D, D, D}; pg8::StaticOrder S; S.init(M, 2 * FF, G, (int)blockIdx.x);
          pg8::EpiSwiglu E{BIG, FF};
          pg8::gemm_phase<pg8::EpiSwiglu, pg8::StaticOrder>(lds, g, S, E, wid); }
        GSYNC();
        { pg8::Gemm g{BIG, W1O, M, D, FF, FF, FF}; pg8::StaticOrder S; S.init(M, D, G, (int)blockIdx.x);
          pg8::EpiResid E{stage == 0 ? x_in : out, out, mod + (stage == 0 ? 0 : 2 * 3 * D) + 2 * D, 0.5f, 0};
          pg8::gemm_phase<pg8::EpiResid, pg8::StaticOrder>(lds, g, S, E, wid); }
        GSYNC();
        if (stage == 1) break;

        modulate_rows(out, a.in[4] + D, mod + 3 * D, H, ngw, wid);
        GSYNC();
        { const int lane = olane(); const float* lp = a.in[9]; const float s01 = wave_sum(lp[lane] * lp[64 + lane]), s23 = wave_sum(lp[128 + lane] * lp[192 + lane]);
          if (wid == 0 && lane == 0) ((LAS float*)sflag)[1] = __expf(s01) - __expf(s23) + 0.2f; }
#pragma unroll 1
        for (int grp = 0; grp < NB / GB; ++grp) {
            { pg8::Gemm g{H + (size_t)grp * MG * D, WIN, MG, INW, D, D, D}; pg8::StaticOrder S; S.init(MG, INW, G, (int)blockIdx.x);
              pg8::EpiProj E{BIG};
              pg8::gemm_phase<pg8::EpiProj, pg8::StaticOrder>(lds, g, S, E, wid); }
            GSYNC();
            for (int kx = 0; kx < 8; ++kx) {
                const int xq = (int)((xbar.x + (unsigned)kx) & 7u);
                for (;;) {
                    if (wid == 0 && olane() == 0) sflag[0] = atomicAdd(ctl + 64 * (grp * 8 + xq), 1u);
                    __syncthreads();
                    const int u = (int)sflag[0];
                    __syncthreads();
                    if (u >= 96) break;
                    int rem = u, typ = 0, qb = 0, which = 0;
                    for (int k = 32; k >= 1; --k) {
                        if (!(k & 1)) { if (rem < 2) { typ = 0; qb = (k >> 1) - 1; which = rem; break; } rem -= 2; }
                        if (k <= 16) { if (rem < 4) { typ = 1; qb = k - 1; which = rem; break; } rem -= 4; }
                    }
                    const int bh = xq + 8 * which;
                    if (typ == 0) att::ret_unit(lds, BIG, bh >> 2, bh & 3, qb, wid);
                    else att::diff_unit(lds, BIG, bh >> 3, bh & 7, qb, (const LAS float*)sflag + 1, a.in[10], wid);
                }
            }
            GSYNC();
            { pg8::StaticOrder S; S.init(MG, D, G, (int)blockIdx.x);
              { pg8::Gemm g{BIG + C_RG, WRO, MG, D, 2048, INW, 2048}; pg8::EpiY E{BIG, C_GT, 0}; pg8::gemm_phase<pg8::EpiY, pg8::StaticOrder>(lds, g, S, E, wid); }
              { pg8::Gemm g{BIG + C_DQ, WDO, MG, D, D, INW, D}; pg8::EpiY E{BIG, C_GT + D, 1}; pg8::gemm_phase<pg8::EpiY, pg8::StaticOrder>(lds, g, S, E, wid); }
              if (grp == 0 && (int)blockIdx.x >= MG / 256 * (D / 256)) {
                  const int nb0 = MG / 256 * (D / 256), nidle = G - nb0;
                  const int lane = olane(), gw2 = opqi(((int)blockIdx.x - nb0) * 8 + wid), ngw2 = nidle * 8;
                  LAS float* scr = (LAS float*)(lds + wid * 16384);
                  constexpr int I_FI = (D / 64) * (2 * FF / 32), I_FO = (FF / 64) * (D / 32);
                  for (int it = gw2; it < I_FI + I_FO; it += ngw2) {
                      if (it < I_FI) tr_item(a.in[13], D, 2 * FF, W1I, 1, scr, it, lane);
                      else tr_item(a.in[14], FF, D, W1O, 0, scr, it - I_FI, lane);
                  }
              } }
            GSYNC();
            { pg8::Gemm g{BIG, WO, MG, D, D, INW, D}; pg8::StaticOrder S; S.init(MG, D, G, (int)blockIdx.x);
              float* o2 = out + (size_t)grp * MG * D;
              pg8::EpiResid E{o2, o2, mod + 3 * D + 2 * D, 1.0f, grp * GB};
              pg8::gemm_phase<pg8::EpiResid, pg8::StaticOrder>(lds, g, S, E, wid); }
            GSYNC();
        }
    }
    const int lane = olane(), gw = opqi(blockIdx.x * 8 + wid);
    for (int m = gw; m < M; m += ngw) {
        f32x4* xr = (f32x4*)(out + (size_t)m * D) + lane;
        f32x4 v[4]; float ss = 0.f;
#pragma unroll
        for (int j = 0; j < 4; ++j) { v[j] = xr[64 * j]; ss += (v[j].x * v[j].x + v[j].y * v[j].y) + (v[j].z * v[j].z + v[j].w * v[j].w); }
        const float rstd = __builtin_amdgcn_rsqf(wave_sum(ss) * (1.f / D) + EPS);
#pragma unroll
        for (int j = 0; j < 4; ++j) { const f32x4 gv = *(const f32x4*)(a.in[15] + 4 * (lane + 64 * j)); xr[64 * j] = v[j] * rstd * gv; }
    }
}

extern "C" void kernel_launch(void* const* d_in, const int* in_sizes, int n_in, void* d_out, int out_size, void* d_ws, size_t ws_size, hipStream_t stream) {
    static int grid = 0;
    if (grid == 0) {
        if (n_in != 16 || out_size != M * D || ws_size < WS_END) { fprintf(stderr, "kernel_launch: unexpected problem (n_in %d out %d ws %zu)\n", n_in, out_size, ws_size); grid = -1; return; }
        int dev = 0, cus = 0, per_cu = 0;
        hipGetDevice(&dev); hipDeviceGetAttribute(&cus, hipDeviceAttributeMultiprocessorCount, dev);
        hipFuncSetAttribute((const void*)mega, hipFuncAttributeMaxDynamicSharedMemorySize, LDS_BYTES);
        hipOccupancyMaxActiveBlocksPerMultiprocessor(&per_cu, (const void*)mega, 512, LDS_BYTES);
        if (per_cu < 1) { fprintf(stderr, "kernel_launch: occupancy query says %d blocks per CU\n", per_cu); per_cu = 1; }
        grid = cus * 1;
    }
    if (grid < 0) return;
    hipMemsetAsync((char*)d_ws + WS_CTL, 0, CTL_ZERO, stream);
    Args a{};
    for (int i = 0; i < 16; ++i) a.in[i] = (const float*)d_in[i];
    a.out = (float*)d_out; a.ws = (unsigned char*)d_ws;
    void* args[] = {&a};
    hipError_t e = hipLaunchCooperativeKernel((const void*)mega, dim3(grid), dim3(512), args, LDS_BYTES, stream);
    if (e != hipSuccess) fprintf(stderr, "cooperative launch failed: %s (grid %d)\n", hipGetErrorString(e), grid);
}
```
